# Optimizing an MI355X kernel written in HIP

```python
import jax, jax.numpy as jnp
from jax import lax
import numpy as np

D_MODEL = 1024
BATCH = 8
SEQ = 4096
DEPTH = 1
DEC_BATCH = 8
DEC_SEQ = 32
PAST_LEN = 4096

CHUNK = 64
SG_CHUNK = 128
D_SG = D_MODEL
SG_GROUPS = 8
SG_GROUP_DIM = D_SG // SG_GROUPS
D_CONV = D_MODEL
CONV_WIDTH = 31
D_FF = 4 * D_MODEL
PLE_DIM = 256
IN_COLS = 2 * D_SG + 2 * D_CONV + 2 * D_MODEL
EPS = 1e-6

kernel_name = "gmlp_conformer_conv_gated_hybrid_step"


def _rmsnorm(x, g):
    xf = x.astype(jnp.float32)
    y = xf * lax.rsqrt(jnp.mean(xf * xf, axis=-1, keepdims=True) + EPS)
    return (y * g.astype(jnp.float32)).astype(x.dtype)


def _layernorm(x, g, b):
    xf = x.astype(jnp.float32)
    mu = jnp.mean(xf, axis=-1, keepdims=True)
    xc = xf - mu
    y = xc * lax.rsqrt(jnp.mean(xc * xc, axis=-1, keepdims=True) + EPS)
    return (y * g.astype(jnp.float32) + b.astype(jnp.float32)).astype(x.dtype)


def _layer(x, p, conv_hist, g_mix, w_in, g_sgv, b_sgv, w_sg, b_sg, w_a, w_dw, b_dw,
           g_cln, b_cln, w_b, w_out, g_ffn, w_up, w_down, g_ple, w_ple_gate, w_ple):
    B, T, _ = x.shape
    n = _rmsnorm(x, g_mix)
    z = n @ w_in
    o1 = D_SG
    o2 = 2 * D_SG
    o3 = o2 + D_CONV
    o4 = o3 + D_CONV
    o5 = o4 + D_MODEL
    u, v, ca, cb, ga, gb = jnp.split(z, [o1, o2, o3, o4, o5], axis=-1)

    vn = _layernorm(v, g_sgv, b_sgv)
    L = min(T, SG_CHUNK)
    vc = vn.reshape(B, T // L, L, SG_GROUPS, SG_GROUP_DIM)
    wm = jnp.tril(w_sg[:, :L, :L])
    s = jnp.einsum('gts,bnsgc->bntgc', wm, vc)
    s = s + jnp.transpose(b_sg[:, :L])[None, None, :, :, None]
    a = u * s.reshape(B, T, D_SG)

    c = ca * jax.nn.sigmoid(cb)
    cfull = jnp.concatenate([conv_hist.astype(c.dtype), c], axis=1)
    dw = lax.conv_general_dilated(
        cfull, w_dw[:, None, :].astype(cfull.dtype), window_strides=(1,), padding='VALID',
        dimension_numbers=('NWC', 'WIO', 'NWC'), feature_group_count=D_CONV) + b_dw
    new_hist = cfull[:, -(CONV_WIDTH - 1):]
    bb = jax.nn.silu(_layernorm(dw, g_cln, b_cln))

    mix = jax.nn.sigmoid(ga) * (a @ w_a) + jax.nn.sigmoid(gb) * (bb @ w_b)
    h = x + mix @ w_out

    f = _rmsnorm(h, g_ffn) @ w_up
    h = h + jnp.square(jax.nn.relu(f)) @ w_down

    gate = jax.nn.sigmoid(_rmsnorm(h, g_ple) @ w_ple_gate)
    h = h + gate * (p @ w_ple)
    return h, new_hist, vn


def setup_inputs(seed: int = 0) -> dict:
    key = jax.random.key(seed)
    ks = jax.random.split(key, 26)
    f32 = jnp.float32

    def nrm(k, shape, scale):
        return jax.random.normal(k, shape, f32) * scale

    def gain(k, shape):
        return 1.0 + 0.02 * jax.random.normal(k, shape, f32)

    return {
        "x_prompt": nrm(ks[0], (BATCH, SEQ, D_MODEL), 1.0),
        "x_sample": nrm(ks[1], (DEC_BATCH, DEC_SEQ, D_MODEL), 1.0),
        "cache_conv": nrm(ks[2], (DEPTH, DEC_BATCH, CONV_WIDTH - 1, D_CONV), 0.5),
        "p_prompt": nrm(ks[3], (DEPTH, BATCH, SEQ, PLE_DIM), 1.0),
        "p_sample": nrm(ks[4], (DEPTH, DEC_BATCH, DEC_SEQ, PLE_DIM), 1.0),
        "g_mix": gain(ks[5], (DEPTH, D_MODEL)),
        "w_in": nrm(ks[6], (DEPTH, D_MODEL, IN_COLS), D_MODEL ** -0.5),
        "g_sgv": gain(ks[7], (DEPTH, D_SG)),
        "b_sgv": nrm(ks[8], (DEPTH, D_SG), 0.02),
        "w_sg": nrm(ks[9], (DEPTH, SG_GROUPS, SG_CHUNK, SG_CHUNK), SG_CHUNK ** -0.5),
        "b_sg": 1.0 + nrm(ks[10], (DEPTH, SG_GROUPS, SG_CHUNK), 0.1),
        "w_a": nrm(ks[11], (DEPTH, D_SG, D_MODEL), D_SG ** -0.5),
        "w_dw": nrm(ks[12], (DEPTH, CONV_WIDTH, D_CONV), CONV_WIDTH ** -0.5),
        "b_dw": nrm(ks[13], (DEPTH, D_CONV), 0.02),
        "g_cln": gain(ks[14], (DEPTH, D_CONV)),
        "b_cln": nrm(ks[15], (DEPTH, D_CONV), 0.02),
        "w_b": nrm(ks[16], (DEPTH, D_CONV, D_MODEL), D_CONV ** -0.5),
        "w_out": nrm(ks[17], (DEPTH, D_MODEL, D_MODEL), D_MODEL ** -0.5),
        "g_ffn": gain(ks[18], (DEPTH, D_MODEL)),
        "w_up": nrm(ks[19], (DEPTH, D_MODEL, D_FF), D_MODEL ** -0.5),
        "w_down": nrm(ks[20], (DEPTH, D_FF, D_MODEL), D_FF ** -0.5),
        "g_ple": gain(ks[21], (DEPTH, D_MODEL)),
        "w_ple_gate": nrm(ks[22], (DEPTH, D_MODEL, D_MODEL), D_MODEL ** -0.5),
        "w_ple": nrm(ks[23], (DEPTH, PLE_DIM, D_MODEL), PLE_DIM ** -0.5),
        "g_final": gain(ks[24], (D_MODEL,)),
    }


def reference(x_prompt, x_sample, cache_conv, p_prompt, p_sample, g_mix, w_in, g_sgv, b_sgv,
              w_sg, b_sg, w_a, w_dw, b_dw, g_cln, b_cln, w_b, w_out, g_ffn, w_up, w_down,
              g_ple, w_ple_gate, w_ple, g_final):
    hp = x_prompt
    hs = x_sample
    conv_p, conv_s, v_s = [], [], []
    for i in range(DEPTH):
        w = (g_mix[i], w_in[i], g_sgv[i], b_sgv[i], w_sg[i], b_sg[i], w_a[i], w_dw[i], b_dw[i],
             g_cln[i], b_cln[i], w_b[i], w_out[i], g_ffn[i], w_up[i], w_down[i],
             g_ple[i], w_ple_gate[i], w_ple[i])
        zero_hist = jnp.zeros((hp.shape[0], CONV_WIDTH - 1, D_CONV), hp.dtype)
        hp, cp, _ = _layer(hp, p_prompt[i], zero_hist, *w)
        hs, cs, vs = _layer(hs, p_sample[i], cache_conv[i], *w)
        conv_p.append(cp)
        conv_s.append(cs)
        v_s.append(vs)
    y_prompt = _rmsnorm(hp, g_final)
    y_sample = _rmsnorm(hs, g_final)
    conv_state_prompt = jnp.stack(conv_p)
    conv_state_sample = jnp.stack(conv_s)
    sg_v_sample = jnp.stack(v_s)
    return (y_prompt, y_sample, conv_state_prompt, conv_state_sample, sg_v_sample)
```

```cpp
#include <hip/hip_runtime.h>
#include <cstdio>
#include <cstdint>

typedef unsigned short bf16;
typedef short bf16x8 __attribute__((ext_vector_type(8)));
typedef float f32x16 __attribute__((ext_vector_type(16)));

constexpr int D = 1024, NB = 8, SEQ = 4096, DB = 8, DSEQ = 32, MP = NB * SEQ, MS = DB * DSEQ, M = MP + MS;
constexpr int FF = 4096, PLE = 256, INC = 6144, CW = 31, HIST = 30;
constexpr float EPS = 1e-6f;

__device__ __forceinline__ bf16 f2bf(float f) { unsigned u = __builtin_bit_cast(unsigned, f); return (bf16)((u + 0x7fffu + ((u >> 16) & 1u)) >> 16); }
__device__ __forceinline__ float bf2f(bf16 b) { return __builtin_bit_cast(float, (unsigned)b << 16); }
__device__ __forceinline__ float sigm(float x) { return 1.f / (1.f + __expf(-x)); }

__global__ void k_tr(const float* __restrict__ W, int K, int N, bf16* __restrict__ WT) {
    size_t idx = (size_t)blockIdx.x * 256 + threadIdx.x; if (idx >= (size_t)K * N) return;
    int n = (int)(idx / K), k = (int)(idx % K); WT[idx] = f2bf(W[(size_t)k * N + n]);
}
__global__ void k_cvt(const float* __restrict__ a, const float* __restrict__ b, size_t na, size_t nb, bf16* __restrict__ o) {
    size_t idx = (size_t)blockIdx.x * 256 + threadIdx.x; if (idx >= na + nb) return;
    o[idx] = f2bf(idx < na ? a[idx] : b[idx - na]);
}
__device__ __forceinline__ float block_sum256(float v, float* sh) {
    for (int o = 1; o < 64; o <<= 1) v += __shfl_xor(v, o);
    __syncthreads(); if ((threadIdx.x & 63) == 0) sh[threadIdx.x >> 6] = v; __syncthreads();
    return sh[0] + sh[1] + sh[2] + sh[3];
}
__global__ void k_rms(const float* __restrict__ xa, const float* __restrict__ xb, const float* __restrict__ g, bf16* __restrict__ O) {
    __shared__ float sh[4];
    const int row = blockIdx.x; const float* x = row < MP ? xa + (size_t)row * D : xb + (size_t)(row - MP) * D;
    float v[4]; float s = 0.f;
    for (int i = 0; i < 4; ++i) { v[i] = x[threadIdx.x + 256 * i]; s += v[i] * v[i]; }
    s = block_sum256(s, sh); const float rs = 1.f / sqrtf(s / D + EPS);
    for (int i = 0; i < 4; ++i) O[(size_t)row * D + threadIdx.x + 256 * i] = f2bf(v[i] * rs * g[threadIdx.x + 256 * i]);
}
__global__ void k_final(float* __restrict__ H, const float* __restrict__ g) {
    __shared__ float sh[4];
    float* x = H + (size_t)blockIdx.x * D; float v[4]; float s = 0.f;
    for (int i = 0; i < 4; ++i) { v[i] = x[threadIdx.x + 256 * i]; s += v[i] * v[i]; }
    s = block_sum256(s, sh); const float rs = 1.f / sqrtf(s / D + EPS);
    for (int i = 0; i < 4; ++i) x[threadIdx.x + 256 * i] = v[i] * rs * g[threadIdx.x + 256 * i];
}
template <class Epi>
__global__ void __launch_bounds__(256) k_gemm(const bf16* __restrict__ A, int lda, const bf16* __restrict__ Bt, int ldb, int K, Epi epi) {
    const int wave = threadIdx.x >> 6, lane = threadIdx.x & 63, r = lane & 31, h = lane >> 5;
    const int row0 = blockIdx.y * 128 + (wave >> 1) * 64, col0 = blockIdx.x * 128 + (wave & 1) * 64;
    f32x16 acc[2][2];
    for (int i = 0; i < 2; ++i) for (int j = 0; j < 2; ++j) for (int e = 0; e < 16; ++e) acc[i][j][e] = 0.f;
    const bf16* ap = A + (size_t)(row0 + r) * lda + 8 * h; const bf16* bp = Bt + (size_t)(col0 + r) * ldb + 8 * h;
    for (int k0 = 0; k0 < K; k0 += 16) {
        bf16x8 a[2], b[2];
        for (int i = 0; i < 2; ++i) { a[i] = *(const bf16x8*)(ap + (size_t)32 * i * lda + k0); b[i] = *(const bf16x8*)(bp + (size_t)32 * i * ldb + k0); }
        for (int i = 0; i < 2; ++i) for (int j = 0; j < 2; ++j) acc[i][j] = __builtin_amdgcn_mfma_f32_32x32x16_bf16(a[i], b[j], acc[i][j], 0, 0, 0);
    }
    for (int i = 0; i < 2; ++i) for (int j = 0; j < 2; ++j) for (int e = 0; e < 16; ++e)
        epi(row0 + 32 * i + (e & 3) + 8 * (e >> 2) + 4 * h, col0 + 32 * j + r, acc[i][j][e]);
}
struct E1 { bf16* Z;
    __device__ void operator()(int row, int col, float v) const { Z[(size_t)(col >> 10) * M * D + (size_t)row * D + (col & 1023)] = f2bf(v); } };
struct E3a { const bf16* GA; bf16* T; __device__ void operator()(int row, int col, float v) const { size_t i = (size_t)row * D + col; T[i] = f2bf(sigm(bf2f(GA[i])) * v); } };
struct E3b { const bf16* GB; const bf16* T; bf16* MIX; __device__ void operator()(int row, int col, float v) const { size_t i = (size_t)row * D + col; MIX[i] = f2bf(bf2f(T[i]) + sigm(bf2f(GB[i])) * v); } };
struct E4 { const float* xa; const float* xb; float* H; __device__ void operator()(int row, int col, float v) const {
    const float x = row < MP ? xa[(size_t)row * D + col] : xb[(size_t)(row - MP) * D + col]; H[(size_t)row * D + col] = x + v; } };
struct E5 { bf16* ACT; __device__ void operator()(int row, int col, float v) const { const float r = v > 0.f ? v : 0.f; ACT[(size_t)row * FF + col] = f2bf(r * r); } };
struct E6 { float* H; __device__ void operator()(int row, int col, float v) const { H[(size_t)row * D + col] += v; } };
struct E7a { bf16* PE; __device__ void operator()(int row, int col, float v) const { PE[(size_t)row * D + col] = f2bf(v); } };
struct E7b { const bf16* PE; float* H; __device__ void operator()(int row, int col, float v) const { size_t i = (size_t)row * D + col; H[i] += sigm(v) * bf2f(PE[i]); } };

__global__ void k_lnv(const bf16* __restrict__ V, const float* __restrict__ g, const float* __restrict__ b, bf16* __restrict__ VN, float* __restrict__ sgv_out) {
    __shared__ float sh[4];
    const int row = blockIdx.x; float v[4]; float s = 0.f;
    for (int i = 0; i < 4; ++i) { v[i] = bf2f(V[(size_t)row * D + threadIdx.x + 256 * i]); s += v[i]; }
    const float mu = block_sum256(s, sh) / D; float q = 0.f;
    for (int i = 0; i < 4; ++i) { v[i] -= mu; q += v[i] * v[i]; }
    const float rstd = 1.f / sqrtf(block_sum256(q, sh) / D + EPS);
    for (int i = 0; i < 4; ++i) { const int c = threadIdx.x + 256 * i; const float y = v[i] * rstd * g[c] + b[c]; VN[(size_t)row * D + c] = f2bf(y);
        if (row >= MP) sgv_out[(size_t)(row - MP) * D + c] = y; }
}
__global__ void k_sg(const bf16* __restrict__ U, const bf16* __restrict__ VN, const float* __restrict__ wsg, const float* __restrict__ bsg, bf16* __restrict__ Aout) {
    const int row = blockIdx.x, t = row < MP ? (row & 127) : ((row - MP) & 31), base = row - t;
    for (int i = 0; i < 4; ++i) { const int c = threadIdx.x + 256 * i, g = c >> 7; const float* w = wsg + ((size_t)g * 128 + t) * 128; float acc = 0.f;
        for (int s = 0; s <= t; ++s) acc += w[s] * bf2f(VN[(size_t)(base + s) * D + c]);
        acc += bsg[g * 128 + t]; Aout[(size_t)row * D + c] = f2bf(bf2f(U[(size_t)row * D + c]) * acc); }
}
__global__ void k_glu(const bf16* __restrict__ CA, const bf16* __restrict__ CB, bf16* __restrict__ C, float* __restrict__ csp, float* __restrict__ css) {
    const int row = blockIdx.x;
    for (int i = 0; i < 4; ++i) { const int c = threadIdx.x + 256 * i; const size_t idx = (size_t)row * D + c; const float v = bf2f(CA[idx]) * sigm(bf2f(CB[idx])); C[idx] = f2bf(v);
        if (row < MP) { const int b = row >> 12, t = row & 4095; if (t >= SEQ - HIST) csp[((size_t)b * HIST + (t - (SEQ - HIST))) * D + c] = v; }
        else { const int b = (row - MP) >> 5, t = (row - MP) & 31; if (t >= DSEQ - HIST) css[((size_t)b * HIST + (t - (DSEQ - HIST))) * D + c] = v; } }
}
__global__ void k_conv(const bf16* __restrict__ C, const float* __restrict__ cache, const float* __restrict__ wdw, const float* __restrict__ bdw,
                       const float* __restrict__ g, const float* __restrict__ bb, bf16* __restrict__ BB) {
    __shared__ float sh[4];
    const int row = blockIdx.x; const bool samp = row >= MP; const int t = samp ? ((row - MP) & 31) : (row & 4095), sb = samp ? ((row - MP) >> 5) : 0;
    float v[4]; float s = 0.f;
    for (int i = 0; i < 4; ++i) { const int c = threadIdx.x + 256 * i; float acc = bdw[c];
        for (int j = 0; j < CW; ++j) { const int tt = t - HIST + j; float x;
            if (tt >= 0) x = bf2f(C[(size_t)(row - t + tt) * D + c]); else x = samp ? cache[((size_t)sb * HIST + (HIST + tt)) * D + c] : 0.f;
            acc += wdw[j * D + c] * x; }
        v[i] = acc; s += acc; }
    const float mu = block_sum256(s, sh) / D; float q = 0.f;
    for (int i = 0; i < 4; ++i) { v[i] -= mu; q += v[i] * v[i]; }
    const float rstd = 1.f / sqrtf(block_sum256(q, sh) / D + EPS);
    for (int i = 0; i < 4; ++i) { const int c = threadIdx.x + 256 * i; const float y = v[i] * rstd * g[c] + bb[c]; BB[(size_t)row * D + c] = f2bf(y * sigm(y)); }
}

extern "C" void kernel_launch(void* const* d_in, const int* in_sizes, int n_in, void* d_out, int out_size, void* d_ws, size_t ws_size, hipStream_t stream) {
    const float* x_p = (const float*)d_in[0]; const float* x_s = (const float*)d_in[1]; const float* cache = (const float*)d_in[2];
    const float* p_p = (const float*)d_in[3]; const float* p_s = (const float*)d_in[4]; const float* g_mix = (const float*)d_in[5];
    const float* w_in = (const float*)d_in[6]; const float* g_sgv = (const float*)d_in[7]; const float* b_sgv = (const float*)d_in[8];
    const float* w_sg = (const float*)d_in[9]; const float* b_sg = (const float*)d_in[10]; const float* w_a = (const float*)d_in[11];
    const float* w_dw = (const float*)d_in[12]; const float* b_dw = (const float*)d_in[13]; const float* g_cln = (const float*)d_in[14];
    const float* b_cln = (const float*)d_in[15]; const float* w_b = (const float*)d_in[16]; const float* w_out = (const float*)d_in[17];
    const float* g_ffn = (const float*)d_in[18]; const float* w_up = (const float*)d_in[19]; const float* w_down = (const float*)d_in[20];
    const float* g_ple = (const float*)d_in[21]; const float* w_pg = (const float*)d_in[22]; const float* w_ple = (const float*)d_in[23];
    const float* g_final = (const float*)d_in[24];
    float* out = (float*)d_out; float* H = out;
    float* csp = out + (size_t)M * D; float* css = csp + (size_t)DB * HIST * D; float* sgv = css + (size_t)DB * HIST * D;
    const size_t MiB = 1u << 20, SLOT = (size_t)M * D * 2;
    if (ws_size < 55 * MiB + 7 * SLOT) { fprintf(stderr, "kernel_launch: workspace too small: %zu\n", ws_size); return; }
    char* ws = (char*)d_ws;
    bf16* WIN = (bf16*)(ws + 1 * MiB); bf16* WA = WIN + (size_t)INC * D; bf16* WB = WA + (size_t)D * D; bf16* WO = WB + (size_t)D * D;
    bf16* WUP = WO + (size_t)D * D; bf16* WDN = WUP + (size_t)FF * D; bf16* WPG = WDN + (size_t)FF * D; bf16* WPL = WPG + (size_t)D * D;
    bf16* PB = (bf16*)(ws + 38 * MiB);
    bf16* S[7]; for (int i = 0; i < 7; ++i) S[i] = (bf16*)(ws + 55 * MiB + i * SLOT);
    auto tr = [&](const float* W, int K, int N, bf16* WT) { k_tr<<<(unsigned)(((size_t)K * N + 255) / 256), 256, 0, stream>>>(W, K, N, WT); };
    tr(w_in, D, INC, WIN); tr(w_a, D, D, WA); tr(w_b, D, D, WB); tr(w_out, D, D, WO); tr(w_up, D, FF, WUP); tr(w_down, FF, D, WDN); tr(w_pg, D, D, WPG); tr(w_ple, PLE, D, WPL);
    k_cvt<<<(unsigned)(((size_t)M * PLE + 255) / 256), 256, 0, stream>>>(p_p, p_s, (size_t)MP * PLE, (size_t)MS * PLE, PB);
    k_rms<<<M, 256, 0, stream>>>(x_p, x_s, g_mix, S[0]);
    k_gemm<E1><<<dim3(INC / 128, M / 128), 256, 0, stream>>>(S[0], D, WIN, D, D, E1{S[1]});
    k_lnv<<<M, 256, 0, stream>>>(S[2], g_sgv, b_sgv, S[0], sgv);
    k_sg<<<M, 256, 0, stream>>>(S[1], S[0], w_sg, b_sg, S[2]);
    k_glu<<<M, 256, 0, stream>>>(S[3], S[4], S[1], csp, css);
    k_conv<<<M, 256, 0, stream>>>(S[1], cache, w_dw, b_dw, g_cln, b_cln, S[0]);
    k_gemm<E3a><<<dim3(D / 128, M / 128), 256, 0, stream>>>(S[2], D, WA, D, D, E3a{S[5], S[1]});
    k_gemm<E3b><<<dim3(D / 128, M / 128), 256, 0, stream>>>(S[0], D, WB, D, D, E3b{S[6], S[1], S[3]});
    k_gemm<E4><<<dim3(D / 128, M / 128), 256, 0, stream>>>(S[3], D, WO, D, D, E4{x_p, x_s, H});
    k_rms<<<M, 256, 0, stream>>>(H, H + (size_t)MP * D, g_ffn, S[0]);
    k_gemm<E5><<<dim3(FF / 128, M / 128), 256, 0, stream>>>(S[0], D, WUP, D, D, E5{S[3]});
    k_gemm<E6><<<dim3(D / 128, M / 128), 256, 0, stream>>>(S[3], FF, WDN, FF, FF, E6{H});
    k_rms<<<M, 256, 0, stream>>>(H, H + (size_t)MP * D, g_ple, S[0]);
    k_gemm<E7a><<<dim3(D / 128, M / 128), 256, 0, stream>>>(PB, PLE, WPL, PLE, PLE, E7a{S[1]});
    k_gemm<E7b><<<dim3(D / 128, M / 128), 256, 0, stream>>>(S[0], D, WPG, D, D, E7b{S[1], H});
    k_final<<<M, 256, 0, stream>>>(H, g_final);
}
```

```cpp
#define MEGA_HI 9
#define ONE_LAUNCH 1
#include <hip/hip_runtime.h>
#include <cstdio>
#include <cstdint>

#define LAS __attribute__((address_space(3)))
#define GAS __attribute__((address_space(1)))
typedef unsigned short bf16;
typedef short bf16x8 __attribute__((ext_vector_type(8)));
typedef float f32x2 __attribute__((ext_vector_type(2)));
typedef float f32x4 __attribute__((ext_vector_type(4)));
typedef float f32x16 __attribute__((ext_vector_type(16)));
typedef unsigned u32x2 __attribute__((ext_vector_type(2)));
typedef unsigned u32x4 __attribute__((ext_vector_type(4)));

constexpr int D = 1024, NB = 8, SEQ = 4096, DB = 8, DSEQ = 32, MP = NB * SEQ, MS = DB * DSEQ, M = MP + MS;
constexpr int FF = 4096, PLE = 256, INC = 6144, CW = 31, HIST = 30;
constexpr float EPS = 1e-6f;
constexpr int NWAVES = 8, NTHR = 512;

constexpr size_t MiB = 1u << 20;
constexpr size_t WS_CTL = 0, CTL_ZERO_BYTES = 64 * 1024;
constexpr size_t WS_WR = 1 * MiB;
constexpr size_t WS_WV = 11 * MiB;
constexpr size_t WS_WA = 13 * MiB, WS_WB = 15 * MiB, WS_WO = 17 * MiB;
constexpr size_t WS_WUP = 19 * MiB;
constexpr size_t WS_WDN = 27 * MiB;
constexpr size_t WS_WPG = 35 * MiB;
constexpr size_t WS_WPL = 37 * MiB;
constexpr size_t WS_WSG = 37 * MiB + 512 * 1024;
constexpr size_t WS_PB = 38 * MiB;
constexpr size_t SLOT = (size_t)M * D * 2;
constexpr size_t WS_S0 = 55 * MiB;
constexpr size_t WS_HSS1 = WS_S0 + 7 * SLOT;
constexpr size_t WS_HSS2 = WS_HSS1 + (size_t)M * 16 * 4;
constexpr size_t WS_PAR = WS_HSS2 + (size_t)M * 16 * 4;
constexpr size_t WS_END = WS_PAR + 1200 * 1024;
static_assert(WS_END <= 512 * MiB, "d_ws map");
constexpr int TP_WR = 0, TP_WV = 20, TP_XN = (int)((WS_S0 - WS_WR) / (512 * 1024));
static_assert((WS_S0 - WS_WR) % (512 * 1024) == 0 && (WS_WV - WS_WR) == 20 * 512 * 1024, "tile alignment");
constexpr int CW_BAR = 1024;

__device__ __forceinline__ unsigned f2bf(float f) { unsigned u = __builtin_bit_cast(unsigned, f); return (u + 0x7fffu + ((u >> 16) & 1u)) >> 16; }
__device__ __forceinline__ unsigned pk2(float lo, float hi) { return f2bf(lo) | (f2bf(hi) << 16); }
__device__ __forceinline__ float bflo(unsigned w) { return __builtin_bit_cast(float, w << 16); }
__device__ __forceinline__ float bfhi(unsigned w) { return __builtin_bit_cast(float, w & 0xffff0000u); }
__device__ __forceinline__ float bf2f(bf16 b) { return __builtin_bit_cast(float, (unsigned)b << 16); }
__device__ __forceinline__ float sigm(float x) { return 1.f / (1.f + __expf(-x)); }
#define LDS_WAIT() asm volatile("s_waitcnt lgkmcnt(0)" ::: "memory")
#define VM_WAIT() asm volatile("s_waitcnt vmcnt(0)" ::: "memory")

namespace pg8 {
constexpr int BM = 256, BK = 64, HALF = 128, HTB = HALF * BK * 2, STAGE_BYTES = 8 * HTB, NXCD = 8, WGM = 8;
__host__ __device__ __forceinline__ int lds_byte(int r, int c) { const int st = (r >> 4) * 2 + (c >> 5), rr = r & 15, cc = c & 31, ob = rr * 64 + cc * 2; return st * 1024 + (ob ^ (((ob >> 9) & 1) << 5)); }
__host__ __device__ __forceinline__ void stage_rc(int b, int& R, int& C) { const int st = b / 1024, sb = b % 1024, swz = sb ^ (((sb >> 9) & 1) << 5); R = (st >> 1) * 16 + swz / 64; C = (st & 1) * 32 + (swz % 64) / 2; }
__host__ __device__ __forceinline__ int perm32(int rho) { const int n = rho >> 4, i = rho & 15; return 8 * (i >> 2) + 4 * n + (i & 3); }

struct Unit { int pm, pn; };
struct Gemm { const char* A0; const char* A1; const char* B0; const char* B1; int lda0, lda1, ldb0, ldb1, nt, ts; };

struct StaticOrder {
    int nM, nN, nwg, G, c;
    __device__ void init(int nM_, int nN_, int G_, int c_) { nM = nM_; nN = nN_; nwg = nM * nN; G = G_; c = c_; }
    __device__ bool next(int i, Unit& u) const {
        const long L = (long)i * G + c; if (L >= nwg) return false;
        int wgid = (int)L; { const int q = nwg / NXCD, r = nwg % NXCD, xcd = wgid % NXCD, off = wgid / NXCD; wgid = (xcd < r ? xcd * (q + 1) : r * (q + 1) + (xcd - r) * q) + off; }
        const int nig = WGM * nN, gid = wgid / nig, fm = gid * WGM, gsz = (nM - fm) < WGM ? (nM - fm) : WGM;
        u.pm = fm + ((wgid % nig) % gsz); u.pn = (wgid % nig) / gsz; return true;
    }
};

template <class Epi, class Sched, bool DIFFLD = false>
__device__ __forceinline__ void gemm_phase(LAS unsigned char* lds, const Gemm g, const Sched& S, const Epi& E, const int tid) {
    const int wid = __builtin_amdgcn_readfirstlane(tid >> 6), lane = tid & 63, wr = wid >> 2, wc = wid & 3, fr = lane & 15, fq = lane >> 4;
    const int nt = g.nt, ts = g.ts;
    int R, C; stage_rc(tid * 16, R, C); const int Rb = Epi::PERM ? ((R & ~31) + perm32(R & 31)) : R;
    const unsigned vA0 = (unsigned)(R * g.lda0 + C) * 2u, vB0 = (unsigned)(Rb * g.ldb0 + C) * 2u;
    const unsigned rc = (unsigned)R | ((unsigned)Rb << 8) | ((unsigned)(2 * C) << 16);
    const size_t hA0 = (size_t)HALF * g.lda0 * 2, hA1 = (size_t)HALF * g.lda1 * 2, hB0 = (size_t)HALF * g.ldb0 * 2, hB1 = (size_t)HALF * g.ldb1 * 2;
    const unsigned ldsw = (unsigned)wid * 1024u;
    const int aoff = lds_byte(wr * 64 + fr, fq * 8), boff = lds_byte(wc * 32 + fr, fq * 8);
#define PG8_SA(b, h) (((b) * 2 + (h)) * HTB)
#define PG8_SB(b, h) ((4 + (b) * 2 + (h)) * HTB)
#define PG8_STAGE(bufoff, gbase, voff, hstep) do { \
        __builtin_amdgcn_global_load_lds((const unsigned*)((const char*)(gbase) + (voff)), (LAS unsigned*)(lds + (bufoff) + ldsw), 16, 0, 0); \
        __builtin_amdgcn_global_load_lds((const unsigned*)((const char*)(gbase) + ((hstep) >> 1) + (voff)), (LAS unsigned*)(lds + (bufoff) + ldsw + 8192), 16, 0, 0); } while (0)
#define PG8_LDA(dst, b, h) do { _Pragma("unroll") for (int m = 0; m < 4; ++m) _Pragma("unroll") for (int k = 0; k < 2; ++k) dst[m][k] = *(const LAS bf16x8*)(lds + PG8_SA(b, h) + aoff + m * 2048 + k * 1024); } while (0)
#define PG8_LDB(dst, b, h) do { _Pragma("unroll") for (int n = 0; n < 2; ++n) _Pragma("unroll") for (int k = 0; k < 2; ++k) dst[n][k] = *(const LAS bf16x8*)(lds + PG8_SB(b, h) + boff + n * 2048 + k * 1024); } while (0)
#define PG8_MMA(ai, bj, At, Bt) do { __builtin_amdgcn_s_setprio(1); _Pragma("unroll") for (int m = 0; m < 4; ++m) _Pragma("unroll") for (int n = 0; n < 2; ++n) _Pragma("unroll") for (int k = 0; k < 2; ++k) \
        acc[ai][bj][m][n] = __builtin_amdgcn_mfma_f32_16x16x32_bf16(Bt[n][k], At[m][k], acc[ai][bj][m][n], 0, 0, 0); __builtin_amdgcn_s_setprio(0); } while (0)
#define PG8_WAIT_V(n) asm volatile("s_waitcnt vmcnt(" #n ")" ::: "memory")
#define PG8_WAIT_L(n) asm volatile("s_waitcnt lgkmcnt(" #n ")" ::: "memory")
#define PG8_BAR __builtin_amdgcn_s_barrier()
#define PG8_SCHED __builtin_amdgcn_sched_barrier(0)
    Unit cur, nxt; int ui = 0;
    if (!S.next(0, cur)) return;
    f32x4 acc[2][2][4][2];
#pragma unroll
    for (int a = 0; a < 2; ++a)
#pragma unroll
        for (int b = 0; b < 2; ++b)
#pragma unroll
            for (int m = 0; m < 4; ++m)
#pragma unroll
                for (int n = 0; n < 2; ++n) acc[a][b][m][n] = (f32x4){0.f, 0.f, 0.f, 0.f};
    bf16x8 At[4][2], B0[2][2], B1[2][2];
    {
        const char* cA = g.A0 + (size_t)cur.pm * (2 * hA0); const char* cB = g.B0 + (size_t)cur.pn * (2 * hB0);
        PG8_STAGE(PG8_SB(0, 0), cB, vB0, hB0); PG8_STAGE(PG8_SB(0, 1), cB + hB0, vB0, hB0); PG8_STAGE(PG8_SA(0, 0), cA, vA0, hA0); PG8_STAGE(PG8_SA(0, 1), cA + hA0, vA0, hA0);
        if (wr == 1) PG8_BAR;
        PG8_WAIT_V(2); PG8_BAR;
        PG8_STAGE(PG8_SB(1, 0), cB + 128, vB0, hB0); PG8_STAGE(PG8_SA(1, 0), cA + 128, vA0, hA0); PG8_STAGE(PG8_SB(1, 1), cB + hB0 + 128, vB0, hB0);
        PG8_WAIT_V(6); PG8_BAR;
    }
    for (;;) {
        const bool has_next = S.next(ui + 1, nxt);
        for (int t = 0; t < nt; t += 2) {
            if constexpr (Epi::HAS_MID) { if (t == ts) E.mid(acc, cur, wr, wc, fr, fq); }
            const bool last = (t == nt - 2);
            const bool sc = t >= ts;
            const char* a1 = sc ? g.A1 + (size_t)cur.pm * (2 * hA1) + (size_t)(t + 1 - ts) * 128 : g.A0 + (size_t)cur.pm * (2 * hA0) + (size_t)(t + 1) * 128;
            unsigned vAc = vA0; if constexpr (DIFFLD) { if (sc) vAc = (rc & 0xffu) * (unsigned)(2 * g.lda1) + (rc >> 16); }
            const size_t hAc = sc ? hA1 : hA0;
            const int upm = (last && has_next) ? nxt.pm : cur.pm, upn = (last && has_next) ? nxt.pn : cur.pn, tt = last ? 0 : t + 2;
            const bool sn = tt >= ts;
            const char* a2 = sn ? g.A1 + (size_t)upm * (2 * hA1) + (size_t)(tt - ts) * 128 : g.A0 + (size_t)upm * (2 * hA0) + (size_t)tt * 128;
            const char* b2 = sn ? g.B1 + (size_t)upn * (2 * hB1) + (size_t)(tt - ts) * 128 : g.B0 + (size_t)upn * (2 * hB0) + (size_t)tt * 128;
            unsigned vAn = vA0, vBn = vB0; if constexpr (DIFFLD) { if (sn) { vAn = (rc & 0xffu) * (unsigned)(2 * g.lda1) + (rc >> 16); vBn = ((rc >> 8) & 0xffu) * (unsigned)(2 * g.ldb1) + (rc >> 16); } }
            const size_t hAn = sn ? hA1 : hA0, hBn = sn ? hB1 : hB0;
            const char* a3 = a2 + 128; const char* b3 = b2 + 128;
            PG8_LDB(B0, 0, 0); PG8_LDB(B1, 0, 1); PG8_SCHED; PG8_LDA(At, 0, 0); PG8_STAGE(PG8_SA(1, 1), a1 + hAc, vAc, hAc);
            PG8_WAIT_V(8); PG8_WAIT_L(0); PG8_BAR; PG8_MMA(0, 0, At, B0); PG8_MMA(0, 1, At, B1); PG8_BAR; PG8_SCHED;
            PG8_LDA(At, 0, 1); PG8_STAGE(PG8_SB(0, 0), b2, vBn, hBn); PG8_STAGE(PG8_SB(0, 1), b2 + hBn, vBn, hBn); PG8_STAGE(PG8_SA(0, 0), a2, vAn, hAn);
            PG8_WAIT_V(8); PG8_WAIT_L(0); PG8_BAR; PG8_MMA(1, 0, At, B0); PG8_MMA(1, 1, At, B1); PG8_BAR; PG8_SCHED;
            PG8_LDB(B0, 1, 0); PG8_LDB(B1, 1, 1); PG8_SCHED; PG8_LDA(At, 1, 0); PG8_STAGE(PG8_SA(0, 1), a2 + hAn, vAn, hAn);
            PG8_WAIT_V(8); PG8_WAIT_L(0); PG8_BAR; PG8_MMA(0, 0, At, B0); PG8_MMA(0, 1, At, B1); PG8_BAR; PG8_SCHED;
            PG8_LDA(At, 1, 1); PG8_STAGE(PG8_SB(1, 0), b3, vBn, hBn); PG8_STAGE(PG8_SB(1, 1), b3 + hBn, vBn, hBn); PG8_STAGE(PG8_SA(1, 0), a3, vAn, hAn);
            PG8_WAIT_V(8); PG8_WAIT_L(0); PG8_BAR; PG8_MMA(1, 0, At, B0); PG8_MMA(1, 1, At, B1); PG8_BAR; PG8_SCHED;
        }
        if (wr == 0) PG8_BAR;
        E(acc, cur, wr, wc, fr, fq);
        if (!has_next) break;
#pragma unroll
        for (int a = 0; a < 2; ++a)
#pragma unroll
            for (int b = 0; b < 2; ++b)
#pragma unroll
                for (int m = 0; m < 4; ++m)
#pragma unroll
                    for (int n = 0; n < 2; ++n) acc[a][b][m][n] = (f32x4){0.f, 0.f, 0.f, 0.f};
        cur = nxt; ++ui;
        if (wr == 1) PG8_BAR;
    }
    PG8_WAIT_V(0);
    PG8_BAR;
#undef PG8_SA
#undef PG8_SB
#undef PG8_STAGE
#undef PG8_LDA
#undef PG8_LDB
#undef PG8_MMA
#undef PG8_WAIT_V
#undef PG8_WAIT_L
#undef PG8_BAR
#undef PG8_SCHED
}
}
constexpr int RING_OFF = 0, RING_BYTES = 131072;
constexpr int LDSCTL_OFF = RING_BYTES, MISC_OFF = LDSCTL_OFF + 320;
constexpr int LDS_BYTES = 147456;
static_assert(MISC_OFF + 128 <= LDS_BYTES, "LDS map");

#define XB_TMO      128
#define XB_XCNT(j)  (256  + 64 * (j))
#define XB_XSUB(j)  (1280 + 64 * (j))
#define XB_XGEN(j)  (2304 + 64 * (j))
#define XB_TOP      3328
#define XB_TOPGEN   3392
#define XCD_BAR_WORDS 3456
#define XB_SPIN_CAP (1u << 18)
__device__ __forceinline__ unsigned xb_ld(unsigned* p)              { return __hip_atomic_load(p, __ATOMIC_RELAXED, __HIP_MEMORY_SCOPE_AGENT); }
__device__ __forceinline__ unsigned xb_add(unsigned* p, unsigned v) { return __hip_atomic_fetch_add(p, v, __ATOMIC_RELAXED, __HIP_MEMORY_SCOPE_AGENT); }
__device__ __forceinline__ unsigned xb_xcc_id() { return (unsigned)__builtin_amdgcn_s_getreg((3 << 11) | 20) & 0xFu; }
#define XB_SPIN(cond, bar) do { unsigned _sp = 0; while (cond) { __builtin_amdgcn_s_sleep(1); \
    if ((++_sp & 255u) == 0u) { if (xb_ld(&(bar)[XB_TMO])) break; if (_sp > XB_SPIN_CAP) { atomicAdd(&(bar)[XB_TMO], 1u); break; } } } } while (0)
struct XcdBarrier { unsigned* bar; unsigned x; volatile LAS unsigned* st; };
__device__ __forceinline__ XcdBarrier xcd_barrier_post(unsigned* bar, volatile LAS unsigned* st, const bool leader) {
    XcdBarrier b; b.bar = bar; b.x = xb_xcc_id(); b.st = st;
    if (leader) (void)xb_add(&bar[XB_XCNT(b.x)], 1u);
    return b;
}
__device__ __forceinline__ void xcd_barrier_complete(unsigned* bar, unsigned x, unsigned& nloc, unsigned& nx) {
    const unsigned G = gridDim.x * gridDim.y * gridDim.z;
    unsigned sum, cnt, mine, sp = 0u;
    for (;;) {
        sum = 0u; cnt = 0u; mine = 0u;
#pragma unroll
        for (unsigned j = 0; j < 16; ++j) { const unsigned c = xb_ld(&bar[XB_XCNT(j)]); sum += c; cnt += (c > 0u) ? 1u : 0u; mine = (j == x) ? c : mine; }
        if (sum == G) break;
        __builtin_amdgcn_s_sleep(1);
        if ((++sp & 255u) == 0u) { if (xb_ld(&bar[XB_TMO])) break; if (sp > XB_SPIN_CAP) { atomicAdd(&bar[XB_TMO], 1u); break; } }
    }
    nloc = mine > 0u ? mine : 1u; nx = cnt > 0u ? cnt : 1u;
}
__device__ __forceinline__ void xcd_barrier(const XcdBarrier& b, const bool leader  ) {
    asm volatile("s_waitcnt vmcnt(0)" ::: "memory");
    __syncthreads();
    if (leader) {
        unsigned* bar = b.bar;
        __builtin_amdgcn_s_waitcnt(0);
        unsigned nloc = b.st[0], nx = b.st[1];
        if (nloc == 0u) { xcd_barrier_complete(bar, b.x, nloc, nx); b.st[0] = nloc; b.st[1] = nx; }
        const unsigned old = xb_add(&bar[XB_XSUB(b.x)], 1u);
        const unsigned gen = old / nloc;
        if (old + 1u == (gen + 1u) * nloc) {
            __builtin_amdgcn_fence(__ATOMIC_RELEASE, "agent");
            asm volatile("s_waitcnt vmcnt(0)" ::: "memory");
            const unsigned og = xb_add(&bar[XB_TOP], 1u);
            const unsigned tg = og / nx;
            if (og + 1u == (tg + 1u) * nx) xb_add(&bar[XB_TOPGEN], 1u);
            else XB_SPIN(xb_ld(&bar[XB_TOPGEN]) == tg, bar);
            __builtin_amdgcn_fence(__ATOMIC_ACQUIRE, "agent");
            xb_add(&bar[XB_XGEN(b.x)], 1u);
            asm volatile("s_waitcnt vmcnt(0)" ::: "memory");
        } else {
            XB_SPIN(xb_ld(&bar[XB_XGEN(b.x)]) == gen, bar);
            __builtin_amdgcn_fence(__ATOMIC_ACQUIRE, "agent");
            asm volatile("s_waitcnt vmcnt(0)" ::: "memory");
        }
    }
    __syncthreads();
}

struct Frame {
    LAS unsigned char* lds;
    int tid, lane, wave, G, vcu;
    float* out; unsigned char* ws;
};
struct Args { const float* in[25]; float* out; unsigned char* ws; int ph_lo, ph_hi; };
constexpr int PO_GSGV = 0, PO_BSGV = 1024, PO_BSG = 2048, PO_BDW = 3072, PO_GCLN = 4096, PO_BCLN = 5120, PO_GFIN = 6144, PO_WDW = 7168, PO_CACHE = PO_WDW + CW * D, PO_END = PO_CACHE + DB * HIST * D;
__device__ __forceinline__ const float* par(const Frame& F, int off) { return (const float*)(F.ws + WS_PAR) + off; }
__device__ __forceinline__ int lane_id() { int l; asm volatile("v_mbcnt_lo_u32_b32 %0, -1, 0\n\tv_mbcnt_hi_u32_b32 %0, -1, %0" : "=v"(l)); return l; }
#define PHASE_IDS(F) do { (F).lane = lane_id(); (F).tid = (F).wave * 64 + (F).lane; } while (0)
__device__ __forceinline__ bf16* wsb(const Frame& F, size_t off) { return (bf16*)(F.ws + off); }
__device__ __forceinline__ bf16* slot(const Frame& F, int i) { return (bf16*)(F.ws + WS_S0 + (size_t)i * SLOT); }
__device__ __forceinline__ float wave_sum(float v) {
#pragma unroll
    for (int o = 1; o < 64; o <<= 1) v += __shfl_xor(v, o);
    return v;
}

__device__ __forceinline__ void tr_item(const float* W, int Nsrc, int K, int k0, int s0, const float* gk, bf16* WT, int d0, LAS float* scr, int lane) {
#pragma unroll 8
    for (int i = 0; i < 32; ++i) { const int kk = 2 * i + (lane >> 5); float v = W[(size_t)(k0 + kk) * Nsrc + s0 + (lane & 31)]; if (gk) v *= gk[k0 + kk]; scr[kk * 33 + (lane & 31)] = v; }
    LDS_WAIT(); asm volatile("" ::: "memory");
    const int c = lane & 7;
#pragma unroll
    for (int j = 0; j < 4; ++j) { const int n = (lane >> 3) + 8 * j; const LAS float* s = scr + (8 * c) * 33 + n;
        u32x4 o; o.x = pk2(s[0 * 33], s[1 * 33]); o.y = pk2(s[2 * 33], s[3 * 33]); o.z = pk2(s[4 * 33], s[5 * 33]); o.w = pk2(s[6 * 33], s[7 * 33]);
        *(u32x4*)(WT + (size_t)(d0 + n) * K + k0 + 8 * c) = o; }
    LDS_WAIT(); asm volatile("" ::: "memory");
}
__device__ __forceinline__ int wr_src_col(int d) {
    if (d < 1024) return d;
    const int base = d < 3072 ? 2048 : 4096, e = d < 3072 ? d - 1024 : d - 3072;
    return base + 1024 * ((e >> 7) & 1) + 128 * (e >> 8) + (e & 127);
}
__device__ __forceinline__ void p0_prologue(Frame& F, const Args& A) {
    LAS float* scr = (LAS float*)(F.lds + RING_OFF + F.wave * 16384);
    const int gw = F.vcu * NWAVES + F.wave, NGW = F.G * NWAVES, lane = F.lane;
    constexpr int I_WR = 16 * 160, I_WV = 16 * 32, I_SQ = 16 * 32, I_UP = 16 * 128, I_DN = 64 * 32, I_PL = 4 * 32;
    constexpr int NITEMS = I_WR + I_WV + 4 * I_SQ + I_UP + I_DN + I_PL;
    for (int it = gw; it < NITEMS; it += NGW) {
        int r = it;
        if (r < I_WR) { const int kb = r / 160, nb = r % 160; tr_item(A.in[6], INC, D, 64 * kb, wr_src_col(32 * nb), nullptr, wsb(F, WS_WR), 32 * nb, scr, lane); continue; } r -= I_WR;
        if (r < I_WV) { const int kb = r / 32, nb = r % 32; tr_item(A.in[6], INC, D, 64 * kb, 1024 + 32 * nb, nullptr, wsb(F, WS_WV), 32 * nb, scr, lane); continue; } r -= I_WV;
        if (r < I_SQ) { const int kb = r / 32, nb = r % 32; tr_item(A.in[11], D, D, 64 * kb, 32 * nb, nullptr, wsb(F, WS_WA), 32 * nb, scr, lane); continue; } r -= I_SQ;
        if (r < I_SQ) { const int kb = r / 32, nb = r % 32; tr_item(A.in[16], D, D, 64 * kb, 32 * nb, nullptr, wsb(F, WS_WB), 32 * nb, scr, lane); continue; } r -= I_SQ;
        if (r < I_SQ) { const int kb = r / 32, nb = r % 32; tr_item(A.in[17], D, D, 64 * kb, 32 * nb, nullptr, wsb(F, WS_WO), 32 * nb, scr, lane); continue; } r -= I_SQ;
        if (r < I_SQ) { const int kb = r / 32, nb = r % 32; tr_item(A.in[22], D, D, 64 * kb, 32 * nb, A.in[21], wsb(F, WS_WPG), 32 * nb, scr, lane); continue; } r -= I_SQ;
        if (r < I_UP) { const int kb = r / 128, nb = r % 128; tr_item(A.in[19], FF, D, 64 * kb, 32 * nb, A.in[18], wsb(F, WS_WUP), 32 * nb, scr, lane); continue; } r -= I_UP;
        if (r < I_DN) { const int kb = r / 32, nb = r % 32; tr_item(A.in[20], D, FF, 64 * kb, 32 * nb, nullptr, wsb(F, WS_WDN), 32 * nb, scr, lane); continue; } r -= I_DN;
        { const int kb = r / 32, nb = r % 32; tr_item(A.in[23], D, PLE, 64 * kb, 32 * nb, nullptr, wsb(F, WS_WPL), 32 * nb, scr, lane); }
    }
    for (int rr = gw; rr < 8 * 128 / 2; rr += NGW) { const int row = 2 * rr + (lane >> 5), t = row & 127, s0 = 4 * (lane & 31);
        const f32x4 w = *(const f32x4*)(A.in[9] + (size_t)row * 128 + s0); u32x2 o;
        o.x = pk2(s0 + 0 <= t ? w.x : 0.f, s0 + 1 <= t ? w.y : 0.f); o.y = pk2(s0 + 2 <= t ? w.z : 0.f, s0 + 3 <= t ? w.w : 0.f);
        *(u32x2*)(wsb(F, WS_WSG) + (size_t)row * 128 + s0) = o; }
    { float* P = (float*)(F.ws + WS_PAR); const int gt = gw * 64 + lane, NT_ = NGW * 64;
      for (int i = gt; i < PO_END / 4; i += NT_) { const int o = 4 * i; const float* src;
          if (o < PO_BSGV) src = A.in[7] + o; else if (o < PO_BSG) src = A.in[8] + (o - PO_BSGV); else if (o < PO_BDW) src = A.in[10] + (o - PO_BSG); else if (o < PO_GCLN) src = A.in[13] + (o - PO_BDW);
          else if (o < PO_BCLN) src = A.in[14] + (o - PO_GCLN); else if (o < PO_GFIN) src = A.in[15] + (o - PO_BCLN); else if (o < PO_WDW) src = A.in[24] + (o - PO_GFIN);
          else if (o < PO_CACHE) src = A.in[12] + (o - PO_WDW); else src = A.in[2] + (o - PO_CACHE);
          *(f32x4*)(P + o) = *(const f32x4*)src; } }
    bf16* XN = slot(F, 0); bf16* PB = wsb(F, WS_PB);
    f32x4 gm[4];
#pragma unroll
    for (int j = 0; j < 4; ++j) gm[j] = *(const f32x4*)(A.in[5] + 4 * lane + 256 * j);
    for (int m = gw; m < M; m += NGW) {
        const float* xr = m < MP ? A.in[0] + (size_t)m * D : A.in[1] + (size_t)(m - MP) * D;
        const float* pr = m < MP ? A.in[3] + (size_t)m * PLE : A.in[4] + (size_t)(m - MP) * PLE;
        f32x4 v[4]; float s = 0.f;
#pragma unroll
        for (int j = 0; j < 4; ++j) { v[j] = *(const f32x4*)(xr + 4 * lane + 256 * j); s += (v[j].x * v[j].x + v[j].y * v[j].y) + (v[j].z * v[j].z + v[j].w * v[j].w); }
        const f32x4 pv = *(const f32x4*)(pr + 4 * lane);
        const float rs = 1.f / sqrtf(wave_sum(s) * (1.f / D) + EPS);
#pragma unroll
        for (int j = 0; j < 4; ++j) { u32x2 o; o.x = pk2(v[j].x * rs * gm[j].x, v[j].y * rs * gm[j].y); o.y = pk2(v[j].z * rs * gm[j].z, v[j].w * rs * gm[j].w);
            *(u32x2*)(XN + (size_t)m * D + 4 * lane + 256 * j) = o; }
        u32x2 po; po.x = pk2(pv.x, pv.y); po.y = pk2(pv.z, pv.w); *(u32x2*)(PB + (size_t)m * PLE + 4 * lane) = po;
    }
}

struct SchedP1 {
    pg8::StaticOrder so;
    __device__ void init(int G, int c) { so.init(M / 256, 24, G, c); }
    __device__ bool next(int i, pg8::Unit& u) const {
        pg8::Unit v; if (!so.next(i, v)) return false;
        if (v.pn < 20) { u.pm = TP_XN + v.pm; u.pn = TP_WR + v.pn; } else { u.pm = TP_WV + (v.pn - 20); u.pn = TP_XN + v.pm; }
        return true;
    }
};
__device__ __forceinline__ u32x4 pack8(const f32x4 a, const f32x4 b) { u32x4 w; w.x = pk2(a.x, a.y); w.y = pk2(a.z, a.w); w.z = pk2(b.x, b.y); w.w = pk2(b.z, b.w); return w; }
struct EpiP1 {
    static constexpr bool PERM = true, HAS_MID = false;
    bf16 *U, *VT, *C, *RR, *SGB; float *csp, *css;
    __device__ __forceinline__ void mid(f32x4 (&acc)[2][2][4][2], const pg8::Unit& u, int wr, int wc, int, int) const {}
    __device__ __forceinline__ void operator()(const f32x4 (&acc)[2][2][4][2], const pg8::Unit& u, int wr, int wc, int, int) const {
        const int lane_ = lane_id(), fr = lane_ & 15, fq = lane_ >> 4;
        if (u.pm >= TP_WV && u.pm < TP_WV + 4) {
            const int ch0 = (u.pm - TP_WV) * 256 + wr * 64 + fr, tok0 = (u.pn - TP_XN) * 256 + wc * 32 + 8 * fq;
#pragma unroll
            for (int ai = 0; ai < 2; ++ai)
#pragma unroll
                for (int m = 0; m < 4; ++m) { bf16* rowp = VT + (size_t)(ch0 + ai * 128 + m * 16) * M + tok0;
#pragma unroll
                    for (int bj = 0; bj < 2; ++bj) *(u32x4*)(rowp + bj * 128) = pack8(acc[ai][bj][m][0], acc[ai][bj][m][1]); }
            return;
        }
        const int row0 = (u.pm - TP_XN) * 256 + wr * 64 + fr, j = u.pn - TP_WR;
        if (j < 4) {
            const int col0 = j * 256 + wc * 32 + 8 * fq;
#pragma unroll
            for (int ai = 0; ai < 2; ++ai)
#pragma unroll
                for (int m = 0; m < 4; ++m) { bf16* rowp = U + (size_t)(row0 + ai * 128 + m * 16) * D + col0;
#pragma unroll
                    for (int bj = 0; bj < 2; ++bj) *(u32x4*)(rowp + bj * 128) = pack8(acc[ai][bj][m][0], acc[ai][bj][m][1]); }
        } else if (j < 12) {
            const int ch0 = (j - 4) * 128 + wc * 32 + 8 * fq;
#pragma unroll
            for (int ai = 0; ai < 2; ++ai)
#pragma unroll
                for (int m = 0; m < 4; ++m) { const int row = row0 + ai * 128 + m * 16; f32x4 c0, c1;
#pragma unroll
                    for (int e = 0; e < 4; ++e) { c0[e] = acc[ai][0][m][0][e] * sigm(acc[ai][1][m][0][e]); c1[e] = acc[ai][0][m][1][e] * sigm(acc[ai][1][m][1][e]); }
                    *(u32x4*)(C + (size_t)row * D + ch0) = pack8(c0, c1);
                    float* cs = nullptr;
                    if (row < MP) { const int t = row & (SEQ - 1); if (t >= SEQ - HIST) cs = csp + ((size_t)(row >> 12) * HIST + (t - (SEQ - HIST))) * D; }
                    else { const int rr = row - MP, t = rr & (DSEQ - 1); if (t >= DSEQ - HIST) cs = css + ((size_t)(rr >> 5) * HIST + (t - (DSEQ - HIST))) * D; }
                    if (cs) { *(f32x4*)(cs + ch0) = c0; *(f32x4*)(cs + ch0 + 4) = c1; } }
        } else {
            const int ch0 = (j - 12) * 128 + wc * 32 + 8 * fq;
#pragma unroll
            for (int ai = 0; ai < 2; ++ai)
#pragma unroll
                for (int m = 0; m < 4; ++m) { const int row = row0 + ai * 128 + m * 16; f32x4 r0, r1, s0, s1;
#pragma unroll
                    for (int e = 0; e < 4; ++e) {
                        const float ea0 = __expf(-acc[ai][0][m][0][e]), eb0 = __expf(-acc[ai][1][m][0][e]), ea1 = __expf(-acc[ai][0][m][1][e]), eb1 = __expf(-acc[ai][1][m][1][e]);
                        s0[e] = 1.f / (1.f + eb0); s1[e] = 1.f / (1.f + eb1); r0[e] = (1.f + eb0) / (1.f + ea0); r1[e] = (1.f + eb1) / (1.f + ea1); }
                    *(u32x4*)(RR + (size_t)row * D + ch0) = pack8(r0, r1); *(u32x4*)(SGB + (size_t)row * D + ch0) = pack8(s0, s1); }
        }
    }
};

template <int NT>
__device__ __forceinline__ void sg_item(Frame& F, int row0, float* sgv_out) {
    LAS float* red = (LAS float*)(F.lds);
    LAS float* ST = (LAS float*)(F.lds + 8192);
    const bf16* VT = slot(F, 2); const bf16* U = slot(F, 1); bf16* A = slot(F, 0); const bf16* WSG = wsb(F, WS_WSG);
    const int lane = F.lane, wave = F.wave, tid = F.tid;
    __syncthreads();
    {
        constexpr int NO = NT / 8, CS = 64 / NO, NI = 1024 / (CS * 8);
        const int o = lane % NO, cs = lane / NO;
        float s[8], q[8];
#pragma unroll
        for (int j = 0; j < 8; ++j) { s[j] = 0.f; q[j] = 0.f; }
#pragma unroll 4
        for (int i = 0; i < NI; ++i) { const int ch = (i * 8 + wave) * CS + cs; const u32x4 v = *(const u32x4*)(VT + (size_t)ch * M + row0 + 8 * o);
#pragma unroll
            for (int j = 0; j < 4; ++j) { const float lo = bflo(v[j]), hi = bfhi(v[j]); s[2 * j] += lo; q[2 * j] += lo * lo; s[2 * j + 1] += hi; q[2 * j + 1] += hi * hi; } }
#pragma unroll
        for (int off = NO; off < 64; off <<= 1)
#pragma unroll
            for (int j = 0; j < 8; ++j) { s[j] += __shfl_xor(s[j], off); q[j] += __shfl_xor(q[j], off); }
        if (lane < NO)
#pragma unroll
            for (int j = 0; j < 8; ++j) { red[(wave * NT + 8 * o + j) * 2] = s[j]; red[(wave * NT + 8 * o + j) * 2 + 1] = q[j]; }
        __syncthreads();
        if (tid < NT) { float S = 0.f, Q = 0.f;
#pragma unroll
            for (int w = 0; w < 8; ++w) { S += red[(w * NT + tid) * 2]; Q += red[(w * NT + tid) * 2 + 1]; }
            const float mu = S * (1.f / D), var = Q * (1.f / D) - mu * mu; ST[2 * tid] = mu; ST[2 * tid + 1] = 1.f / sqrtf(var + EPS); }
        __syncthreads();
    }
    const int r = lane & 31, h = lane >> 5;
    auto afrag = [&](const bf16* vrow, int ks, float gam, float bet, float* sg_dst) -> bf16x8 {
        const u32x4 v = *(const u32x4*)(vrow + 16 * ks);
        const LAS f32x4* st = (const LAS f32x4*)(ST + 2 * (16 * ks + 8 * h));
        float y[8];
#pragma unroll
        for (int p = 0; p < 4; ++p) { const f32x4 s4 = st[p];
            y[2 * p] = (bflo(v[p]) - s4.x) * (s4.y * gam) + bet; y[2 * p + 1] = (bfhi(v[p]) - s4.z) * (s4.w * gam) + bet; }
        if (sg_dst)
#pragma unroll
            for (int j = 0; j < 8; ++j) sg_dst[(size_t)(16 * ks + 8 * h + j) * D] = y[j];
        u32x4 w; w.x = pk2(y[0], y[1]); w.y = pk2(y[2], y[3]); w.z = pk2(y[4], y[5]); w.w = pk2(y[6], y[7]);
        return __builtin_bit_cast(bf16x8, w);
    };
    auto epi = [&](const f32x16& acc, int g, int cb, int tb) {
        const int t = 32 * tb + r, row = row0 + t; const float bias = par(F, PO_BSG)[g * 128 + t];
#pragma unroll
        for (int eg = 0; eg < 4; ++eg) { const size_t off = (size_t)row * D + g * 128 + cb * 32 + 8 * eg + 4 * h; const u32x2 uu = *(const u32x2*)(U + off);
            u32x2 o; o.x = pk2(bflo(uu.x) * (acc[4 * eg] + bias), bfhi(uu.x) * (acc[4 * eg + 1] + bias)); o.y = pk2(bflo(uu.y) * (acc[4 * eg + 2] + bias), bfhi(uu.y) * (acc[4 * eg + 3] + bias));
            *(u32x2*)(A + off) = o; }
    };
    if constexpr (NT == 128) {
        const int cb = wave & 3, tbA = (wave >> 2) ? 1 : 0, tbB = (wave >> 2) ? 2 : 3, nks = 2 * (tbB + 1), nksA = 2 * (tbA + 1);
        for (int g = 0; g < 8; ++g) {
            const int ch = g * 128 + cb * 32 + r; const float gam = par(F, PO_GSGV)[ch], bet = par(F, PO_BSGV)[ch];
            const bf16* vrow = VT + (size_t)ch * M + row0 + 8 * h;
            const bf16* wA = WSG + ((size_t)g * 128 + 32 * tbA + r) * 128 + 8 * h; const bf16* wB = WSG + ((size_t)g * 128 + 32 * tbB + r) * 128 + 8 * h;
            f32x16 accA, accB;
#pragma unroll
            for (int e = 0; e < 16; ++e) { accA[e] = 0.f; accB[e] = 0.f; }
            for (int ks = 0; ks < nks; ++ks) {
                const bf16x8 a = afrag(vrow, ks, gam, bet, nullptr);
                const bf16x8 bB = *(const bf16x8*)(wB + 16 * ks); accB = __builtin_amdgcn_mfma_f32_32x32x16_bf16(a, bB, accB, 0, 0, 0);
                if (ks < nksA) { const bf16x8 bA = *(const bf16x8*)(wA + 16 * ks); accA = __builtin_amdgcn_mfma_f32_32x32x16_bf16(a, bA, accA, 0, 0, 0); }
            }
            epi(accA, g, cb, tbA); epi(accB, g, cb, tbB);
        }
    } else {
        const int g = wave;
        for (int cb = 0; cb < 4; ++cb) {
            const int ch = g * 128 + cb * 32 + r; const float gam = par(F, PO_GSGV)[ch], bet = par(F, PO_BSGV)[ch];
            const bf16* vrow = VT + (size_t)ch * M + row0 + 8 * h; const bf16* wA = WSG + ((size_t)g * 128 + r) * 128 + 8 * h;
            f32x16 acc;
#pragma unroll
            for (int e = 0; e < 16; ++e) acc[e] = 0.f;
#pragma unroll
            for (int ks = 0; ks < 2; ++ks) { const bf16x8 a = afrag(vrow, ks, gam, bet, sgv_out + ch); const bf16x8 b = *(const bf16x8*)(wA + 16 * ks);
                acc = __builtin_amdgcn_mfma_f32_32x32x16_bf16(a, b, acc, 0, 0, 0); }
            epi(acc, g, cb, 0);
        }
    }
}
template <int NT>
__device__ __forceinline__ void conv_item(Frame& F, int row0, int hist_mode  , const float* cache_b) {
    LAS float* wred = (LAS float*)(F.lds + CW * D * 4);
    LAS float* ST2 = (LAS float*)(F.lds + CW * D * 4 + 1024);
    const bf16* C = slot(F, 3); bf16* BB = slot(F, 6);
    const int tid = F.tid, lane = F.lane, wave = F.wave, c2 = 2 * tid;
    LAS float* wl = (LAS float*)(F.lds);
    __syncthreads();
    { const float* wp = par(F, PO_WDW) + 4 * tid;
#pragma unroll 4
      for (int i = 0; i < (CW * D + 4 * NTHR - 1) / (4 * NTHR); ++i) { if (4 * tid + i * 4 * NTHR < CW * D) *(LAS f32x4*)(wl + 4 * tid + i * 4 * NTHR) = *(const f32x4*)(wp + i * 4 * NTHR); } }
    const f32x2 bd = *(const f32x2*)(par(F, PO_BDW) + c2), gc = *(const f32x2*)(par(F, PO_GCLN) + c2), bc = *(const f32x2*)(par(F, PO_BCLN) + c2);
    __syncthreads();
    f32x2 win[HIST + 8];
#pragma unroll
    for (int i = 0; i < HIST + 8; ++i) win[i] = (f32x2){0.f, 0.f};
    if (hist_mode == 1) {
        const bf16* hp = C + (size_t)(row0 - HIST) * D + c2;
#pragma unroll
        for (int i = 0; i < HIST; ++i) { const unsigned v = *(const unsigned*)hp; win[i] = (f32x2){bflo(v), bfhi(v)}; hp += D; asm volatile("" : "+v"(hp)); }
    } else if (hist_mode == 2) {
        const float* hp = cache_b + c2;
#pragma unroll
        for (int i = 0; i < HIST; ++i) { win[i] = *(const f32x2*)hp; hp += D; asm volatile("" : "+v"(hp)); }
    }
    const bf16* cp = C + (size_t)row0 * D + c2; bf16* op = BB + (size_t)row0 * D + c2;
#pragma clang loop unroll(disable)
    for (int base = 0; base < NT; base += 8) {
        unsigned raw[8];
#pragma unroll
        for (int i = 0; i < 8; ++i) raw[i] = *(const unsigned*)(cp + (size_t)i * D);
        f32x2 dw[8]; float x[16];
#pragma unroll
        for (int i = 0; i < 8; ++i) { win[HIST + i] = (f32x2){bflo(raw[i]), bfhi(raw[i])}; dw[i] = bd; }
#pragma unroll
        for (int j = 0; j < CW; ++j) { const f32x2 wj = *(const LAS f32x2*)(wl + j * D + c2);
#pragma unroll
            for (int i = 0; i < 8; ++i) dw[i] += wj * win[i + j]; }
#pragma unroll
        for (int i = 0; i < 8; ++i) { x[2 * i] = dw[i].x + dw[i].y; x[2 * i + 1] = dw[i].x * dw[i].x + dw[i].y * dw[i].y; }
#pragma unroll
        for (int i = 0; i < HIST; ++i) win[i] = win[i + 8];
#pragma unroll
        for (int st = 0; st < 4; ++st) { const int n = 8 >> st, bit = 32 >> st; const bool up = (lane & bit) != 0;
#pragma unroll
            for (int i = 0; i < n; ++i) { const float keep = up ? x[i + n] : x[i], send = up ? x[i] : x[i + n]; x[i] = keep + __shfl_xor(send, bit); } }
        x[0] += __shfl_xor(x[0], 2); x[0] += __shfl_xor(x[0], 1);
        __syncthreads();
        if ((lane & 3) == 0) wred[wave * 16 + (lane >> 2)] = x[0];
        __syncthreads();
        if (tid < 16) { float tot = 0.f;
#pragma unroll
            for (int wv = 0; wv < 8; ++wv) tot += wred[wv * 16 + tid];
            const float oth = __shfl_xor(tot, 1);
            if ((tid & 1) == 0) { const float mu = tot * (1.f / D), var = oth * (1.f / D) - mu * mu; ST2[tid] = mu; ST2[tid + 1] = 1.f / sqrtf(var + EPS); } }
        __syncthreads();
#pragma unroll
        for (int i = 0; i < 8; ++i) { const f32x2 ms = *(const LAS f32x2*)(ST2 + 2 * i);
            const float y0 = (dw[i].x - ms.x) * ms.y * gc.x + bc.x, y1 = (dw[i].y - ms.x) * ms.y * gc.y + bc.y;
            *(unsigned*)(op + (size_t)i * D) = pk2(y0 * sigm(y0), y1 * sigm(y1)); }
        cp += 8 * D; op += 8 * D;
    }
}
__device__ __forceinline__ void p2_mixers(Frame& F) {
    float* sgv = F.out + (size_t)M * D + 2 * (size_t)DB * HIST * D;
    for (int it = F.vcu; it < 2 * (MP / 128 + DB); it += F.G) {
        if (it < MP / 128) sg_item<128>(F, it * 128, nullptr);
        else if (it < MP / 128 + DB) { const int b = it - MP / 128; sg_item<32>(F, MP + 32 * b, sgv + (size_t)b * DSEQ * D); }
        else if (it < 2 * (MP / 128) + DB) { const int c = it - (MP / 128 + DB); conv_item<128>(F, c * 128, (c & 31) ? 1 : 0, nullptr); }
        else { const int b = it - (2 * (MP / 128) + DB); conv_item<32>(F, MP + 32 * b, 2, par(F, PO_CACHE) + (size_t)b * HIST * D); }
    }
}
struct SchedStd {
    pg8::StaticOrder so;
    __device__ void init(int nM, int nN, int G, int c) { so.init(nM, nN, G, c); }
    __device__ bool next(int i, pg8::Unit& u) const { return so.next(i, u); }
};
__device__ __forceinline__ void mul8(f32x4& a, f32x4& b, const u32x4 w) {
    a.x *= bflo(w.x); a.y *= bfhi(w.x); a.z *= bflo(w.y); a.w *= bfhi(w.y); b.x *= bflo(w.z); b.y *= bfhi(w.z); b.z *= bflo(w.w); b.w *= bfhi(w.w);
}
struct EpiP3 {
    static constexpr bool PERM = true, HAS_MID = true;
    const bf16 *RR, *SGB; bf16* MIX;
    __device__ __forceinline__ void mid(f32x4 (&acc)[2][2][4][2], const pg8::Unit& u, int wr, int wc, int, int) const {
        const int lane_ = lane_id(), fr = lane_ & 15, fq = lane_ >> 4;
        const int row0 = u.pm * 256 + wr * 64 + fr, col0 = u.pn * 256 + wc * 32 + 8 * fq;
#pragma unroll
        for (int ai = 0; ai < 2; ++ai)
#pragma unroll
            for (int m = 0; m < 4; ++m) { const bf16* rowp = RR + (size_t)(row0 + ai * 128 + m * 16) * D + col0;
#pragma unroll
                for (int bj = 0; bj < 2; ++bj) { const u32x4 w = *(const u32x4*)(rowp + bj * 128); mul8(acc[ai][bj][m][0], acc[ai][bj][m][1], w); }
                if (m & 1) asm volatile("" ::: "memory"); }
    }
    __device__ __forceinline__ void operator()(const f32x4 (&acc)[2][2][4][2], const pg8::Unit& u, int wr, int wc, int, int) const {
        const int lane_ = lane_id(), fr = lane_ & 15, fq = lane_ >> 4;
        const int row0 = u.pm * 256 + wr * 64 + fr, col0 = u.pn * 256 + wc * 32 + 8 * fq;
#pragma unroll
        for (int ai = 0; ai < 2; ++ai)
#pragma unroll
            for (int m = 0; m < 4; ++m) { const size_t off = (size_t)(row0 + ai * 128 + m * 16) * D + col0;
#pragma unroll
                for (int bj = 0; bj < 2; ++bj) { const u32x4 w = *(const u32x4*)(SGB + off + bj * 128); f32x4 a = acc[ai][bj][m][0], b = acc[ai][bj][m][1]; mul8(a, b, w);
                    *(u32x4*)(MIX + off + bj * 128) = pack8(a, b); }
                if (m & 1) asm volatile("" ::: "memory"); }
    }
};
struct EpiP4 {
    static constexpr bool PERM = true, HAS_MID = false;
    const float *xp, *xs; float* H; bf16* HB; float* HSS;
    __device__ __forceinline__ void mid(f32x4 (&acc)[2][2][4][2], const pg8::Unit& u, int wr, int wc, int, int) const {}
    __device__ __forceinline__ void operator()(const f32x4 (&acc)[2][2][4][2], const pg8::Unit& u, int wr, int wc, int, int) const {
        const int lane_ = lane_id(), fr = lane_ & 15, fq = lane_ >> 4;
        const int row0 = u.pm * 256 + wr * 64 + fr, col0 = u.pn * 256 + wc * 32 + 8 * fq;
#pragma unroll
        for (int ai = 0; ai < 2; ++ai)
#pragma unroll
            for (int m = 0; m < 4; ++m) { const int row = row0 + ai * 128 + m * 16; const float* xr = (row < MP ? xp + (size_t)row * D : xs + (size_t)(row - MP) * D) + col0; const size_t off = (size_t)row * D + col0; float ss = 0.f;
#pragma unroll
                for (int bj = 0; bj < 2; ++bj) { const f32x4 h0 = *(const f32x4*)(xr + bj * 128) + acc[ai][bj][m][0], h1 = *(const f32x4*)(xr + bj * 128 + 4) + acc[ai][bj][m][1];
                    *(f32x4*)(H + off + bj * 128) = h0; *(f32x4*)(H + off + bj * 128 + 4) = h1; *(u32x4*)(HB + off + bj * 128) = pack8(h0, h1);
                    ss += (h0.x * h0.x + h0.y * h0.y) + (h0.z * h0.z + h0.w * h0.w) + (h1.x * h1.x + h1.y * h1.y) + (h1.z * h1.z + h1.w * h1.w); }
                ss += __shfl_xor(ss, 16); ss += __shfl_xor(ss, 32);
                if (fq == 0) HSS[(size_t)row * 16 + u.pn * 4 + wc] = ss;
                if (m & 1) asm volatile("" ::: "memory"); }
    }
};
struct EpiP5 {
    static constexpr bool PERM = true, HAS_MID = false;
    bf16* ACT;
    __device__ __forceinline__ void mid(f32x4 (&acc)[2][2][4][2], const pg8::Unit& u, int wr, int wc, int, int) const {}
    __device__ __forceinline__ void operator()(const f32x4 (&acc)[2][2][4][2], const pg8::Unit& u, int wr, int wc, int, int) const {
        const int lane_ = lane_id(), fr = lane_ & 15, fq = lane_ >> 4;
        const int row0 = u.pm * 256 + wr * 64 + fr, col0 = u.pn * 256 + wc * 32 + 8 * fq;
#pragma unroll
        for (int ai = 0; ai < 2; ++ai)
#pragma unroll
            for (int m = 0; m < 4; ++m) { bf16* rowp = ACT + (size_t)(row0 + ai * 128 + m * 16) * FF + col0;
#pragma unroll
                for (int bj = 0; bj < 2; ++bj) { f32x4 a = acc[ai][bj][m][0], b = acc[ai][bj][m][1];
#pragma unroll
                    for (int e = 0; e < 4; ++e) { const float ra = a[e] > 0.f ? a[e] : 0.f, rb = b[e] > 0.f ? b[e] : 0.f; a[e] = ra * ra; b[e] = rb * rb; }
                    *(u32x4*)(rowp + bj * 128) = pack8(a, b); } }
    }
};
__device__ __forceinline__ float row_ss16(const float* p) {
    const f32x4 a = *(const f32x4*)p, b = *(const f32x4*)(p + 4), c = *(const f32x4*)(p + 8), d = *(const f32x4*)(p + 12);
    return ((a.x + a.y) + (a.z + a.w)) + ((b.x + b.y) + (b.z + b.w)) + ((c.x + c.y) + (c.z + c.w)) + ((d.x + d.y) + (d.z + d.w));
}
struct EpiP6 {
    static constexpr bool PERM = true, HAS_MID = false;
    float* H; bf16* HB; const float* HSS1; float* HSS2;
    __device__ __forceinline__ void mid(f32x4 (&acc)[2][2][4][2], const pg8::Unit& u, int wr, int wc, int, int) const {}
    __device__ __forceinline__ void operator()(const f32x4 (&acc)[2][2][4][2], const pg8::Unit& u, int wr, int wc, int, int) const {
        const int lane_ = lane_id(), fr = lane_ & 15, fq = lane_ >> 4;
        const int row0 = u.pm * 256 + wr * 64 + fr, col0 = u.pn * 256 + wc * 32 + 8 * fq;
#pragma unroll
        for (int ai = 0; ai < 2; ++ai)
#pragma unroll
            for (int m = 0; m < 4; ++m) { const int row = row0 + ai * 128 + m * 16; const size_t off = (size_t)row * D + col0; float ss = 0.f;
                const float rinv = 1.f / (row_ss16(HSS1 + (size_t)row * 16) * (1.f / D) + EPS);
#pragma unroll
                for (int bj = 0; bj < 2; ++bj) { const f32x4 h0 = *(const f32x4*)(H + off + bj * 128) + acc[ai][bj][m][0] * rinv, h1 = *(const f32x4*)(H + off + bj * 128 + 4) + acc[ai][bj][m][1] * rinv;
                    *(f32x4*)(H + off + bj * 128) = h0; *(f32x4*)(H + off + bj * 128 + 4) = h1; *(u32x4*)(HB + off + bj * 128) = pack8(h0, h1);
                    ss += (h0.x * h0.x + h0.y * h0.y) + (h0.z * h0.z + h0.w * h0.w) + (h1.x * h1.x + h1.y * h1.y) + (h1.z * h1.z + h1.w * h1.w); }
                ss += __shfl_xor(ss, 16); ss += __shfl_xor(ss, 32);
                if (fq == 0) HSS2[(size_t)row * 16 + u.pn * 4 + wc] = ss;
                if (m & 1) asm volatile("" ::: "memory"); }
    }
};
struct EpiP7 {
    static constexpr bool PERM = true, HAS_MID = true;
    float* H; bf16* PE; const float* HSS2;
    __device__ __forceinline__ void mid(f32x4 (&acc)[2][2][4][2], const pg8::Unit& u, int wr, int wc, int, int) const {
        const int lane_ = lane_id(), fr = lane_ & 15, fq = lane_ >> 4;
        const int row0 = u.pm * 256 + wr * 64 + fr, col0 = u.pn * 256 + wc * 32 + 8 * fq;
#pragma unroll
        for (int ai = 0; ai < 2; ++ai)
#pragma unroll
            for (int m = 0; m < 4; ++m) { bf16* rowp = PE + (size_t)(row0 + ai * 128 + m * 16) * D + col0;
#pragma unroll
                for (int bj = 0; bj < 2; ++bj) { *(u32x4*)(rowp + bj * 128) = pack8(acc[ai][bj][m][0], acc[ai][bj][m][1]); acc[ai][bj][m][0] = (f32x4){0.f, 0.f, 0.f, 0.f}; acc[ai][bj][m][1] = (f32x4){0.f, 0.f, 0.f, 0.f}; } }
    }
    __device__ __forceinline__ void operator()(const f32x4 (&acc)[2][2][4][2], const pg8::Unit& u, int wr, int wc, int, int) const {
        const int lane_ = lane_id(), fr = lane_ & 15, fq = lane_ >> 4;
        const int row0 = u.pm * 256 + wr * 64 + fr, col0 = u.pn * 256 + wc * 32 + 8 * fq;
#pragma unroll
        for (int ai = 0; ai < 2; ++ai)
#pragma unroll
            for (int m = 0; m < 4; ++m) { const int row = row0 + ai * 128 + m * 16; const size_t off = (size_t)row * D + col0;
                const float rs = 1.f / sqrtf(row_ss16(HSS2 + (size_t)row * 16) * (1.f / D) + EPS);
#pragma unroll
                for (int bj = 0; bj < 2; ++bj) { const u32x4 w = *(const u32x4*)(PE + off + bj * 128); f32x4 g0, g1;
#pragma unroll
                    for (int e = 0; e < 4; ++e) { g0[e] = sigm(rs * acc[ai][bj][m][0][e]); g1[e] = sigm(rs * acc[ai][bj][m][1][e]); }
                    mul8(g0, g1, w);
                    *(f32x4*)(H + off + bj * 128) = *(const f32x4*)(H + off + bj * 128) + g0; *(f32x4*)(H + off + bj * 128 + 4) = *(const f32x4*)(H + off + bj * 128 + 4) + g1; }
                asm volatile("" ::: "memory"); }
    }
};
__device__ __forceinline__ void p8_final(Frame& F) {
    const int gw = F.vcu * NWAVES + F.wave, NGW = F.G * NWAVES, lane = F.lane;
    f32x4 gf[4];
#pragma unroll
    for (int j = 0; j < 4; ++j) gf[j] = *(const f32x4*)(par(F, PO_GFIN) + 4 * lane + 256 * j);
    for (int m = gw; m < M; m += NGW) { float* xr = F.out + (size_t)m * D + 4 * lane; f32x4 v[4]; float s = 0.f;
#pragma unroll
        for (int j = 0; j < 4; ++j) { v[j] = *(const f32x4*)(xr + 256 * j); s += (v[j].x * v[j].x + v[j].y * v[j].y) + (v[j].z * v[j].z + v[j].w * v[j].w); }
        const float rs = 1.f / sqrtf(wave_sum(s) * (1.f / D) + EPS);
#pragma unroll
        for (int j = 0; j < 4; ++j) *(f32x4*)(xr + 256 * j) = v[j] * rs * gf[j]; }
}

constexpr int N_PHASES = 9;
__global__ void __launch_bounds__(NTHR, 2) mega_fwd(Args args) {
    extern __shared__ __attribute__((aligned(16))) unsigned char lds[];
    Frame F;
    F.lds = (LAS unsigned char*)lds;
    F.wave = __builtin_amdgcn_readfirstlane((int)threadIdx.x >> 6); PHASE_IDS(F);
    F.G = gridDim.x; { const int bx = blockIdx.x; F.vcu = (F.G % 8 == 0) ? (bx % 8) * (F.G / 8) + bx / 8 : bx; }
    F.out = args.out; F.ws = args.ws;
    volatile LAS unsigned* MISC = (volatile LAS unsigned*)(F.lds + MISC_OFF);
    for (int u = F.tid; u < (LDS_BYTES - LDSCTL_OFF) / 4; u += NTHR) ((LAS unsigned*)(F.lds + LDSCTL_OFF))[u] = 0u;
    __syncthreads();
    const int lo = args.ph_lo, hi = args.ph_hi;
    XcdBarrier bar; bar.bar = (unsigned*)(F.ws + WS_CTL) + CW_BAR; bar.x = 0; bar.st = nullptr;
    if (hi - lo > 1) bar = xcd_barrier_post((unsigned*)(F.ws + WS_CTL) + CW_BAR, MISC + 8, F.wave == 0 && F.lane == 0);
#ifndef PHASE_MASK
#define PHASE_MASK 0x1ff
#endif
#define IN(k) (((PHASE_MASK >> (k)) & 1) && lo <= (k) && (k) < hi)
#define SEAM(k) do { if (IN(k) && IN((k) + 1)) xcd_barrier(bar, F.wave == 0 && lane_id() == 0); } while (0)
    float* csp = F.out + (size_t)M * D; float* css = csp + (size_t)DB * HIST * D;
    float* HSS1 = (float*)(F.ws + WS_HSS1); float* HSS2 = (float*)(F.ws + WS_HSS2);
    const char* wbase = (const char*)(F.ws + WS_WR);

    if (IN(0)) { PHASE_IDS(F); p0_prologue(F, args); SEAM(0); }
    if (IN(1)) {
        pg8::Gemm g{wbase, wbase, wbase, wbase, D, D, D, D, 16, 16}; SchedP1 S; S.init(F.G, (int)blockIdx.x);
        EpiP1 E{slot(F, 1), slot(F, 2), slot(F, 3), slot(F, 4), slot(F, 5), csp, css};
        PHASE_IDS(F); pg8::gemm_phase<EpiP1, SchedP1>(F.lds + RING_OFF, g, S, E, F.tid);
        SEAM(1);
    }
    if (IN(2)) { PHASE_IDS(F); p2_mixers(F); SEAM(2); }
    if (IN(3)) {
        pg8::Gemm g{(const char*)slot(F, 0), (const char*)slot(F, 6), (const char*)(F.ws + WS_WA), (const char*)(F.ws + WS_WB), D, D, D, D, 32, 16}; SchedStd S; S.init(M / 256, 4, F.G, (int)blockIdx.x);
        EpiP3 E{slot(F, 4), slot(F, 5), slot(F, 1)};
        PHASE_IDS(F); pg8::gemm_phase<EpiP3, SchedStd>(F.lds + RING_OFF, g, S, E, F.tid);
        SEAM(3);
    }
    if (IN(4)) {
        const char* a = (const char*)slot(F, 1); const char* b = (const char*)(F.ws + WS_WO);
        pg8::Gemm g{a, a, b, b, D, D, D, D, 16, 16}; SchedStd S; S.init(M / 256, 4, F.G, (int)blockIdx.x);
        EpiP4 E{args.in[0], args.in[1], F.out, slot(F, 2), HSS1};
        PHASE_IDS(F); pg8::gemm_phase<EpiP4, SchedStd>(F.lds + RING_OFF, g, S, E, F.tid);
        SEAM(4);
    }
    if (IN(5)) {
        const char* a = (const char*)slot(F, 2); const char* b = (const char*)(F.ws + WS_WUP);
        pg8::Gemm g{a, a, b, b, D, D, D, D, 16, 16}; SchedStd S; S.init(M / 256, FF / 256, F.G, (int)blockIdx.x);
        EpiP5 E{slot(F, 3)};
        PHASE_IDS(F); pg8::gemm_phase<EpiP5, SchedStd>(F.lds + RING_OFF, g, S, E, F.tid);
        SEAM(5);
    }
    if (IN(6)) {
        const char* a = (const char*)slot(F, 3); const char* b = (const char*)(F.ws + WS_WDN);
        pg8::Gemm g{a, a, b, b, FF, FF, FF, FF, 64, 64}; SchedStd S; S.init(M / 256, 4, F.G, (int)blockIdx.x);
        EpiP6 E{F.out, slot(F, 0), HSS1, HSS2};
        PHASE_IDS(F); pg8::gemm_phase<EpiP6, SchedStd>(F.lds + RING_OFF, g, S, E, F.tid);
        SEAM(6);
    }
    if (IN(7)) {
        pg8::Gemm g{(const char*)(F.ws + WS_PB), (const char*)slot(F, 0), (const char*)(F.ws + WS_WPL), (const char*)(F.ws + WS_WPG), PLE, D, PLE, D, 20, 4}; SchedStd S; S.init(M / 256, 4, F.G, (int)blockIdx.x);
        EpiP7 E{F.out, slot(F, 1), HSS2};
        PHASE_IDS(F); pg8::gemm_phase<EpiP7, SchedStd, true>(F.lds + RING_OFF, g, S, E, F.tid);
        SEAM(7);
    }
    if (IN(8)) { PHASE_IDS(F); p8_final(F); }
#undef IN
#undef SEAM
}
#ifndef MEGA_HI
#define MEGA_HI 9
#endif
#ifndef ONE_LAUNCH
#define ONE_LAUNCH 1
#endif
#if MEGA_HI < 9
__device__ __forceinline__ float block_sum256(float v, float* sh) {
    for (int o = 1; o < 64; o <<= 1) v += __shfl_xor(v, o);
    __syncthreads(); if ((threadIdx.x & 63) == 0) sh[threadIdx.x >> 6] = v; __syncthreads();
    return sh[0] + sh[1] + sh[2] + sh[3];
}
__global__ void k_rms(const float* __restrict__ X, bf16* __restrict__ O) {
    __shared__ float sh[4];
    const int row = blockIdx.x; const float* x = X + (size_t)row * D; float v[4]; float s = 0.f;
    for (int i = 0; i < 4; ++i) { v[i] = x[threadIdx.x + 256 * i]; s += v[i] * v[i]; }
    s = block_sum256(s, sh); const float rs = 1.f / sqrtf(s / D + EPS);
    for (int i = 0; i < 4; ++i) O[(size_t)row * D + threadIdx.x + 256 * i] = (bf16)f2bf(v[i] * rs);
}
__global__ void k_final(float* __restrict__ H, const float* __restrict__ g) {
    __shared__ float sh[4];
    float* x = H + (size_t)blockIdx.x * D; float v[4]; float s = 0.f;
    for (int i = 0; i < 4; ++i) { v[i] = x[threadIdx.x + 256 * i]; s += v[i] * v[i]; }
    s = block_sum256(s, sh); const float rs = 1.f / sqrtf(s / D + EPS);
    for (int i = 0; i < 4; ++i) x[threadIdx.x + 256 * i] = v[i] * rs * g[threadIdx.x + 256 * i];
}
template <class Epi>
__global__ void __launch_bounds__(256) k_gemm(const bf16* __restrict__ A, int lda, const bf16* __restrict__ Bt, int ldb, int K, Epi epi) {
    const int wave = threadIdx.x >> 6, lane = threadIdx.x & 63, r = lane & 31, h = lane >> 5;
    const int row0 = blockIdx.y * 128 + (wave >> 1) * 64, col0 = blockIdx.x * 128 + (wave & 1) * 64;
    f32x16 acc[2][2];
    for (int i = 0; i < 2; ++i) for (int j = 0; j < 2; ++j) for (int e = 0; e < 16; ++e) acc[i][j][e] = 0.f;
    const bf16* ap = A + (size_t)(row0 + r) * lda + 8 * h; const bf16* bp = Bt + (size_t)(col0 + r) * ldb + 8 * h;
    for (int k0 = 0; k0 < K; k0 += 16) {
        bf16x8 a[2], b[2];
        for (int i = 0; i < 2; ++i) { a[i] = *(const bf16x8*)(ap + (size_t)32 * i * lda + k0); b[i] = *(const bf16x8*)(bp + (size_t)32 * i * ldb + k0); }
        for (int i = 0; i < 2; ++i) for (int j = 0; j < 2; ++j) acc[i][j] = __builtin_amdgcn_mfma_f32_32x32x16_bf16(a[i], b[j], acc[i][j], 0, 0, 0);
    }
    for (int i = 0; i < 2; ++i) for (int j = 0; j < 2; ++j) for (int e = 0; e < 16; ++e)
        epi(row0 + 32 * i + (e & 3) + 8 * (e >> 2) + 4 * h, col0 + 32 * j + r, acc[i][j][e]);
}
struct E3a { const bf16* RR; bf16* T; __device__ void operator()(int row, int col, float v) const { size_t i = (size_t)row * D + col; T[i] = (bf16)f2bf(bf2f(RR[i]) * v); } };
struct E3b { const bf16* SGB; const bf16* T; bf16* MIX; __device__ void operator()(int row, int col, float v) const { size_t i = (size_t)row * D + col; MIX[i] = (bf16)f2bf(bf2f(SGB[i]) * (bf2f(T[i]) + v)); } };
struct E4 { const float* xa; const float* xb; float* H; __device__ void operator()(int row, int col, float v) const {
    const float x = row < MP ? xa[(size_t)row * D + col] : xb[(size_t)(row - MP) * D + col]; H[(size_t)row * D + col] = x + v; } };
struct E5 { bf16* ACT; __device__ void operator()(int row, int col, float v) const { const float r = v > 0.f ? v : 0.f; ACT[(size_t)row * FF + col] = (bf16)f2bf(r * r); } };
struct E6 { float* H; __device__ void operator()(int row, int col, float v) const { H[(size_t)row * D + col] += v; } };
struct E7a { bf16* PE; __device__ void operator()(int row, int col, float v) const { PE[(size_t)row * D + col] = (bf16)f2bf(v); } };
struct E7b { const bf16* PE; float* H; __device__ void operator()(int row, int col, float v) const { size_t i = (size_t)row * D + col; H[i] += sigm(v) * bf2f(PE[i]); } };
#endif

extern "C" void kernel_launch(void* const* d_in, const int* in_sizes, int n_in, void* d_out, int out_size, void* d_ws, size_t ws_size, hipStream_t stream) {
    static int grid = 0;
    if (grid == 0) {
        if (n_in != 25 || in_sizes[0] != MP * D || out_size != M * D + 2 * DB * HIST * D + MS * D || ws_size < WS_END) {
            fprintf(stderr, "kernel_launch: unexpected shapes: n_in %d, in0 %d, out %d, ws %zu (need %zu); nothing launched\n", n_in, n_in > 0 ? in_sizes[0] : -1, out_size, ws_size, (size_t)WS_END); grid = -1; return; }
        int dev = 0, cus = 0, per_cu = 0;
        if (hipGetDevice(&dev) != hipSuccess || hipDeviceGetAttribute(&cus, hipDeviceAttributeMultiprocessorCount, dev) != hipSuccess) { fprintf(stderr, "kernel_launch: device query failed\n"); grid = -1; return; }
        if (hipFuncSetAttribute((const void*)mega_fwd, hipFuncAttributeMaxDynamicSharedMemorySize, LDS_BYTES) != hipSuccess) { fprintf(stderr, "kernel_launch: hipFuncSetAttribute failed\n"); grid = -1; return; }
        if (hipOccupancyMaxActiveBlocksPerMultiprocessor(&per_cu, (const void*)mega_fwd, NTHR, LDS_BYTES) != hipSuccess || per_cu < 1)
            fprintf(stderr, "kernel_launch: note: occupancy query reports %d workgroups per CU\n", per_cu);
        (void)hipGetLastError();
        grid = cus;
    }
    if (grid < 0) return;
    if (hipMemsetAsync((char*)d_ws + WS_CTL, 0, CTL_ZERO_BYTES, stream) != hipSuccess) { fprintf(stderr, "kernel_launch: memset failed\n"); return; }
    Args a{};
    for (int i = 0; i < 25; ++i) a.in[i] = (const float*)d_in[i];
    a.out = (float*)d_out; a.ws = (unsigned char*)d_ws;
#if ONE_LAUNCH
    a.ph_lo = 0; a.ph_hi = MEGA_HI;
    hipLaunchKernelGGL(mega_fwd, dim3(grid), dim3(NTHR), LDS_BYTES, stream, a);
#else
    for (int ph = 0; ph < MEGA_HI; ++ph) { a.ph_lo = ph; a.ph_hi = ph + 1; hipLaunchKernelGGL(mega_fwd, dim3(grid), dim3(NTHR), LDS_BYTES, stream, a); }
#endif
    { const hipError_t le = hipPeekAtLastError(); if (le != hipSuccess) fprintf(stderr, "kernel_launch: launch failed: %s\n", hipGetErrorName(le)); }
#if MEGA_HI < 9
    char* ws = (char*)d_ws; float* H = (float*)d_out;
    auto S = [&](int i) { return (bf16*)(ws + WS_S0 + (size_t)i * SLOT); };
    const float* x_p = (const float*)d_in[0]; const float* x_s = (const float*)d_in[1];
    if (MEGA_HI <= 3) {
        k_gemm<E3a><<<dim3(D / 128, M / 128), 256, 0, stream>>>(S(0), D, (const bf16*)(ws + WS_WA), D, D, E3a{S(4), S(2)});
        k_gemm<E3b><<<dim3(D / 128, M / 128), 256, 0, stream>>>(S(6), D, (const bf16*)(ws + WS_WB), D, D, E3b{S(5), S(2), S(1)});
    }
    if (MEGA_HI <= 4) k_gemm<E4><<<dim3(D / 128, M / 128), 256, 0, stream>>>(S(1), D, (const bf16*)(ws + WS_WO), D, D, E4{x_p, x_s, H});
    if (MEGA_HI <= 5) {
        k_rms<<<M, 256, 0, stream>>>(H, S(2));
        k_gemm<E5><<<dim3(FF / 128, M / 128), 256, 0, stream>>>(S(2), D, (const bf16*)(ws + WS_WUP), D, D, E5{S(3)});
        k_gemm<E6><<<dim3(D / 128, M / 128), 256, 0, stream>>>(S(3), FF, (const bf16*)(ws + WS_WDN), FF, FF, E6{H});
    }
    if (MEGA_HI <= 7) {
        k_rms<<<M, 256, 0, stream>>>(H, S(0));
        k_gemm<E7a><<<dim3(D / 128, M / 128), 256, 0, stream>>>((const bf16*)(ws + WS_PB), PLE, (const bf16*)(ws + WS_WPL), PLE, PLE, E7a{S(1)});
        k_gemm<E7b><<<dim3(D / 128, M / 128), 256, 0, stream>>>(S(0), D, (const bf16*)(ws + WS_WPG), D, D, E7b{S(1), H});
    }
    k_final<<<M, 256, 0, stream>>>(H, (const float*)d_in[24]);
#endif
}
```

```cpp
#define MEGA_HI 9
#define ONE_LAUNCH 1
#include <hip/hip_runtime.h>
#include <cstdio>
#include <cstdint>

#define LAS __attribute__((address_space(3)))
#define GAS __attribute__((address_space(1)))
typedef unsigned short bf16;
typedef short bf16x8 __attribute__((ext_vector_type(8)));
typedef float f32x2 __attribute__((ext_vector_type(2)));
typedef float f32x4 __attribute__((ext_vector_type(4)));
typedef float f32x16 __attribute__((ext_vector_type(16)));
typedef unsigned u32x2 __attribute__((ext_vector_type(2)));
typedef unsigned u32x4 __attribute__((ext_vector_type(4)));

constexpr int D = 1024, NB = 8, SEQ = 4096, DB = 8, DSEQ = 32, MP = NB * SEQ, MS = DB * DSEQ, M = MP + MS;
constexpr int FF = 4096, PLE = 256, INC = 6144, CW = 31, HIST = 30;
constexpr float EPS = 1e-6f;
constexpr int NWAVES = 8, NTHR = 512;

constexpr size_t MiB = 1u << 20;
constexpr size_t WS_CTL = 0, CTL_ZERO_BYTES = 64 * 1024;
constexpr size_t WS_WR = 1 * MiB;
constexpr size_t WS_WV = 11 * MiB;
constexpr size_t WS_WA = 13 * MiB, WS_WB = 15 * MiB, WS_WO = 17 * MiB;
constexpr size_t WS_WUP = 19 * MiB;
constexpr size_t WS_WDN = 27 * MiB;
constexpr size_t WS_WPG = 35 * MiB;
constexpr size_t WS_WPL = 37 * MiB;
constexpr size_t WS_WSG = 37 * MiB + 512 * 1024;
constexpr size_t WS_PB = 38 * MiB;
constexpr size_t SLOT = (size_t)M * D * 2;
constexpr size_t WS_S0 = 55 * MiB;
constexpr size_t WS_HSS1 = WS_S0 + 7 * SLOT;
constexpr size_t WS_HSS2 = WS_HSS1 + (size_t)M * 16 * 4;
constexpr size_t WS_PAR = WS_HSS2 + (size_t)M * 16 * 4;
constexpr size_t WS_END = WS_PAR + 1200 * 1024;
static_assert(WS_END <= 512 * MiB, "d_ws map");
constexpr int TP_WR = 0, TP_WV = 20, TP_XN = (int)((WS_S0 - WS_WR) / (512 * 1024));
static_assert((WS_S0 - WS_WR) % (512 * 1024) == 0 && (WS_WV - WS_WR) == 20 * 512 * 1024, "tile alignment");
constexpr int CW_BAR = 1024;

__device__ __forceinline__ unsigned f2bf(float f) { unsigned u = __builtin_bit_cast(unsigned, f); return (u + 0x7fffu + ((u >> 16) & 1u)) >> 16; }
__device__ __forceinline__ unsigned pk2(float lo, float hi) { return f2bf(lo) | (f2bf(hi) << 16); }
__device__ __forceinline__ float bflo(unsigned w) { return __builtin_bit_cast(float, w << 16); }
__device__ __forceinline__ float bfhi(unsigned w) { return __builtin_bit_cast(float, w & 0xffff0000u); }
__device__ __forceinline__ float bf2f(bf16 b) { return __builtin_bit_cast(float, (unsigned)b << 16); }
__device__ __forceinline__ float sigm(float x) { return 1.f / (1.f + __expf(-x)); }
#define LDS_WAIT() asm volatile("s_waitcnt lgkmcnt(0)" ::: "memory")
#define VM_WAIT() asm volatile("s_waitcnt vmcnt(0)" ::: "memory")

namespace pg8 {
constexpr int BM = 256, BK = 64, HALF = 128, HTB = HALF * BK * 2, STAGE_BYTES = 8 * HTB, NXCD = 8, WGM = 8;
__host__ __device__ __forceinline__ int lds_byte(int r, int c) { const int st = (r >> 4) * 2 + (c >> 5), rr = r & 15, cc = c & 31, ob = rr * 64 + cc * 2; return st * 1024 + (ob ^ (((ob >> 9) & 1) << 5)); }
__host__ __device__ __forceinline__ void stage_rc(int b, int& R, int& C) { const int st = b / 1024, sb = b % 1024, swz = sb ^ (((sb >> 9) & 1) << 5); R = (st >> 1) * 16 + swz / 64; C = (st & 1) * 32 + (swz % 64) / 2; }
__host__ __device__ __forceinline__ int perm32(int rho) { const int n = rho >> 4, i = rho & 15; return 8 * (i >> 2) + 4 * n + (i & 3); }

struct Unit { int pm, pn; };
struct Gemm { const char* A0; const char* A1; const char* B0; const char* B1; int lda0, lda1, ldb0, ldb1, nt, ts; };

struct StaticOrder {
    int nM, nN, nwg, G, c;
    __device__ void init(int nM_, int nN_, int G_, int c_) { nM = nM_; nN = nN_; nwg = nM * nN; G = G_; c = c_; }
    __device__ bool next(int i, Unit& u) const {
        const long L = (long)i * G + c; if (L >= nwg) return false;
        int wgid = (int)L; { const int q = nwg / NXCD, r = nwg % NXCD, xcd = wgid % NXCD, off = wgid / NXCD; wgid = (xcd < r ? xcd * (q + 1) : r * (q + 1) + (xcd - r) * q) + off; }
        const int nig = WGM * nN, gid = wgid / nig, fm = gid * WGM, gsz = (nM - fm) < WGM ? (nM - fm) : WGM;
        u.pm = fm + ((wgid % nig) % gsz); u.pn = (wgid % nig) / gsz; return true;
    }
};

template <class Epi, class Sched, bool DIFFLD = false>
__device__ __forceinline__ void gemm_phase(LAS unsigned char* lds, const Gemm g, const Sched& S, const Epi& E, const int tid) {
    const int wid = __builtin_amdgcn_readfirstlane(tid >> 6), lane = tid & 63, wr = wid >> 2, wc = wid & 3, fr = lane & 15, fq = lane >> 4;
    const int nt = g.nt, ts = g.ts;
    int R, C; stage_rc(tid * 16, R, C); const int Rb = Epi::PERM ? ((R & ~31) + perm32(R & 31)) : R;
    const unsigned vA0 = (unsigned)(R * g.lda0 + C) * 2u, vB0 = (unsigned)(Rb * g.ldb0 + C) * 2u;
    const unsigned rc = (unsigned)R | ((unsigned)Rb << 8) | ((unsigned)(2 * C) << 16);
    const size_t hA0 = (size_t)HALF * g.lda0 * 2, hA1 = (size_t)HALF * g.lda1 * 2, hB0 = (size_t)HALF * g.ldb0 * 2, hB1 = (size_t)HALF * g.ldb1 * 2;
    const unsigned ldsw = (unsigned)wid * 1024u;
    const int aoff = lds_byte(wr * 64 + fr, fq * 8), boff = lds_byte(wc * 32 + fr, fq * 8);
#define PG8_SA(b, h) (((b) * 2 + (h)) * HTB)
#define PG8_SB(b, h) ((4 + (b) * 2 + (h)) * HTB)
#define PG8_STAGE(bufoff, gbase, voff, hstep) do { \
        __builtin_amdgcn_global_load_lds((const unsigned*)((const char*)(gbase) + (voff)), (LAS unsigned*)(lds + (bufoff) + ldsw), 16, 0, 0); \
        __builtin_amdgcn_global_load_lds((const unsigned*)((const char*)(gbase) + ((hstep) >> 1) + (voff)), (LAS unsigned*)(lds + (bufoff) + ldsw + 8192), 16, 0, 0); } while (0)
#define PG8_LDA(dst, b, h) do { _Pragma("unroll") for (int m = 0; m < 4; ++m) _Pragma("unroll") for (int k = 0; k < 2; ++k) dst[m][k] = *(const LAS bf16x8*)(lds + PG8_SA(b, h) + aoff + m * 2048 + k * 1024); } while (0)
#define PG8_LDB(dst, b, h) do { _Pragma("unroll") for (int n = 0; n < 2; ++n) _Pragma("unroll") for (int k = 0; k < 2; ++k) dst[n][k] = *(const LAS bf16x8*)(lds + PG8_SB(b, h) + boff + n * 2048 + k * 1024); } while (0)
#define PG8_MMA(ai, bj, At, Bt) do { __builtin_amdgcn_s_setprio(1); _Pragma("unroll") for (int m = 0; m < 4; ++m) _Pragma("unroll") for (int n = 0; n < 2; ++n) _Pragma("unroll") for (int k = 0; k < 2; ++k) \
        acc[ai][bj][m][n] = __builtin_amdgcn_mfma_f32_16x16x32_bf16(Bt[n][k], At[m][k], acc[ai][bj][m][n], 0, 0, 0); __builtin_amdgcn_s_setprio(0); } while (0)
#define PG8_WAIT_V(n) asm volatile("s_waitcnt vmcnt(" #n ")" ::: "memory")
#define PG8_WAIT_L(n) asm volatile("s_waitcnt lgkmcnt(" #n ")" ::: "memory")
#define PG8_BAR __builtin_amdgcn_s_barrier()
#define PG8_SCHED __builtin_amdgcn_sched_barrier(0)
    Unit cur, nxt; int ui = 0;
    if (!S.next(0, cur)) return;
    f32x4 acc[2][2][4][2];
#pragma unroll
    for (int a = 0; a < 2; ++a)
#pragma unroll
        for (int b = 0; b < 2; ++b)
#pragma unroll
            for (int m = 0; m < 4; ++m)
#pragma unroll
                for (int n = 0; n < 2; ++n) acc[a][b][m][n] = (f32x4){0.f, 0.f, 0.f, 0.f};
    bf16x8 At[4][2], B0[2][2], B1[2][2];
    {
        const char* cA = g.A0 + (size_t)cur.pm * (2 * hA0); const char* cB = g.B0 + (size_t)cur.pn * (2 * hB0);
        PG8_STAGE(PG8_SB(0, 0), cB, vB0, hB0); PG8_STAGE(PG8_SB(0, 1), cB + hB0, vB0, hB0); PG8_STAGE(PG8_SA(0, 0), cA, vA0, hA0); PG8_STAGE(PG8_SA(0, 1), cA + hA0, vA0, hA0);
        if (wr == 1) PG8_BAR;
        PG8_WAIT_V(2); PG8_BAR;
        PG8_STAGE(PG8_SB(1, 0), cB + 128, vB0, hB0); PG8_STAGE(PG8_SA(1, 0), cA + 128, vA0, hA0); PG8_STAGE(PG8_SB(1, 1), cB + hB0 + 128, vB0, hB0);
        PG8_WAIT_V(6); PG8_BAR;
    }
    for (;;) {
        const bool has_next = S.next(ui + 1, nxt);
        for (int t = 0; t < nt; t += 2) {
            if constexpr (Epi::HAS_MID) { if (t == ts) E.mid(acc, cur, wr, wc, fr, fq); }
            const bool last = (t == nt - 2);
            const bool sc = t >= ts;
            const char* a1 = sc ? g.A1 + (size_t)cur.pm * (2 * hA1) + (size_t)(t + 1 - ts) * 128 : g.A0 + (size_t)cur.pm * (2 * hA0) + (size_t)(t + 1) * 128;
            unsigned vAc = vA0; if constexpr (DIFFLD) { if (sc) vAc = (rc & 0xffu) * (unsigned)(2 * g.lda1) + (rc >> 16); }
            const size_t hAc = sc ? hA1 : hA0;
            const int upm = (last && has_next) ? nxt.pm : cur.pm, upn = (last && has_next) ? nxt.pn : cur.pn, tt = last ? 0 : t + 2;
            const bool sn = tt >= ts;
            const char* a2 = sn ? g.A1 + (size_t)upm * (2 * hA1) + (size_t)(tt - ts) * 128 : g.A0 + (size_t)upm * (2 * hA0) + (size_t)tt * 128;
            const char* b2 = sn ? g.B1 + (size_t)upn * (2 * hB1) + (size_t)(tt - ts) * 128 : g.B0 + (size_t)upn * (2 * hB0) + (size_t)tt * 128;
            unsigned vAn = vA0, vBn = vB0; if constexpr (DIFFLD) { if (sn) { vAn = (rc & 0xffu) * (unsigned)(2 * g.lda1) + (rc >> 16); vBn = ((rc >> 8) & 0xffu) * (unsigned)(2 * g.ldb1) + (rc >> 16); } }
            const size_t hAn = sn ? hA1 : hA0, hBn = sn ? hB1 : hB0;
            const char* a3 = a2 + 128; const char* b3 = b2 + 128;
            PG8_LDB(B0, 0, 0); PG8_LDB(B1, 0, 1); PG8_SCHED; PG8_LDA(At, 0, 0); PG8_STAGE(PG8_SA(1, 1), a1 + hAc, vAc, hAc);
            PG8_WAIT_V(8); PG8_WAIT_L(0); PG8_BAR; PG8_MMA(0, 0, At, B0); PG8_MMA(0, 1, At, B1); PG8_BAR; PG8_SCHED;
            PG8_LDA(At, 0, 1); PG8_STAGE(PG8_SB(0, 0), b2, vBn, hBn); PG8_STAGE(PG8_SB(0, 1), b2 + hBn, vBn, hBn); PG8_STAGE(PG8_SA(0, 0), a2, vAn, hAn);
            PG8_WAIT_V(8); PG8_WAIT_L(0); PG8_BAR; PG8_MMA(1, 0, At, B0); PG8_MMA(1, 1, At, B1); PG8_BAR; PG8_SCHED;
            PG8_LDB(B0, 1, 0); PG8_LDB(B1, 1, 1); PG8_SCHED; PG8_LDA(At, 1, 0); PG8_STAGE(PG8_SA(0, 1), a2 + hAn, vAn, hAn);
            PG8_WAIT_V(8); PG8_WAIT_L(0); PG8_BAR; PG8_MMA(0, 0, At, B0); PG8_MMA(0, 1, At, B1); PG8_BAR; PG8_SCHED;
            PG8_LDA(At, 1, 1); PG8_STAGE(PG8_SB(1, 0), b3, vBn, hBn); PG8_STAGE(PG8_SB(1, 1), b3 + hBn, vBn, hBn); PG8_STAGE(PG8_SA(1, 0), a3, vAn, hAn);
            PG8_WAIT_V(8); PG8_WAIT_L(0); PG8_BAR; PG8_MMA(1, 0, At, B0); PG8_MMA(1, 1, At, B1); PG8_BAR; PG8_SCHED;
        }
        if (wr == 0) PG8_BAR;
        E(acc, cur, wr, wc, fr, fq);
        if (!has_next) break;
#pragma unroll
        for (int a = 0; a < 2; ++a)
#pragma unroll
            for (int b = 0; b < 2; ++b)
#pragma unroll
                for (int m = 0; m < 4; ++m)
#pragma unroll
                    for (int n = 0; n < 2; ++n) acc[a][b][m][n] = (f32x4){0.f, 0.f, 0.f, 0.f};
        cur = nxt; ++ui;
        if (wr == 1) PG8_BAR;
    }
    PG8_WAIT_V(0);
    PG8_BAR;
#undef PG8_SA
#undef PG8_SB
#undef PG8_STAGE
#undef PG8_LDA
#undef PG8_LDB
#undef PG8_MMA
#undef PG8_WAIT_V
#undef PG8_WAIT_L
#undef PG8_BAR
#undef PG8_SCHED
}
}
constexpr int RING_OFF = 0, RING_BYTES = 131072;
constexpr int LDSCTL_OFF = RING_BYTES, MISC_OFF = LDSCTL_OFF + 320;
constexpr int LDS_BYTES = 147456;
static_assert(MISC_OFF + 128 <= LDS_BYTES, "LDS map");

#define XB_TMO      128
#define XB_XCNT(j)  (256  + 64 * (j))
#define XB_XSUB(j)  (1280 + 64 * (j))
#define XB_XGEN(j)  (2304 + 64 * (j))
#define XB_TOP      3328
#define XB_TOPGEN   3392
#define XCD_BAR_WORDS 3456
#define XB_SPIN_CAP (1u << 18)
__device__ __forceinline__ unsigned xb_ld(unsigned* p)              { return __hip_atomic_load(p, __ATOMIC_RELAXED, __HIP_MEMORY_SCOPE_AGENT); }
__device__ __forceinline__ unsigned xb_add(unsigned* p, unsigned v) { return __hip_atomic_fetch_add(p, v, __ATOMIC_RELAXED, __HIP_MEMORY_SCOPE_AGENT); }
__device__ __forceinline__ unsigned xb_xcc_id() { return (unsigned)__builtin_amdgcn_s_getreg((3 << 11) | 20) & 0xFu; }
#define XB_SPIN(cond, bar) do { unsigned _sp = 0; while (cond) { __builtin_amdgcn_s_sleep(1); \
    if ((++_sp & 255u) == 0u) { if (xb_ld(&(bar)[XB_TMO])) break; if (_sp > XB_SPIN_CAP) { atomicAdd(&(bar)[XB_TMO], 1u); break; } } } } while (0)
struct XcdBarrier { unsigned* bar; unsigned x; volatile LAS unsigned* st; };
__device__ __forceinline__ XcdBarrier xcd_barrier_post(unsigned* bar, volatile LAS unsigned* st, const bool leader) {
    XcdBarrier b; b.bar = bar; b.x = xb_xcc_id(); b.st = st;
    if (leader) (void)xb_add(&bar[XB_XCNT(b.x)], 1u);
    return b;
}
__device__ __forceinline__ void xcd_barrier_complete(unsigned* bar, unsigned x, unsigned& nloc, unsigned& nx) {
    const unsigned G = gridDim.x * gridDim.y * gridDim.z;
    unsigned sum, cnt, mine, sp = 0u;
    for (;;) {
        sum = 0u; cnt = 0u; mine = 0u;
#pragma unroll
        for (unsigned j = 0; j < 16; ++j) { const unsigned c = xb_ld(&bar[XB_XCNT(j)]); sum += c; cnt += (c > 0u) ? 1u : 0u; mine = (j == x) ? c : mine; }
        if (sum == G) break;
        __builtin_amdgcn_s_sleep(1);
        if ((++sp & 255u) == 0u) { if (xb_ld(&bar[XB_TMO])) break; if (sp > XB_SPIN_CAP) { atomicAdd(&bar[XB_TMO], 1u); break; } }
    }
    nloc = mine > 0u ? mine : 1u; nx = cnt > 0u ? cnt : 1u;
}
__device__ __forceinline__ void xcd_barrier(const XcdBarrier& b, const bool leader  ) {
    asm volatile("s_waitcnt vmcnt(0)" ::: "memory");
    __syncthreads();
    if (leader) {
        unsigned* bar = b.bar;
        __builtin_amdgcn_s_waitcnt(0);
        unsigned nloc = b.st[0], nx = b.st[1];
        if (nloc == 0u) { xcd_barrier_complete(bar, b.x, nloc, nx); b.st[0] = nloc; b.st[1] = nx; }
        const unsigned old = xb_add(&bar[XB_XSUB(b.x)], 1u);
        const unsigned gen = old / nloc;
        if (old + 1u == (gen + 1u) * nloc) {
            __builtin_amdgcn_fence(__ATOMIC_RELEASE, "agent");
            asm volatile("s_waitcnt vmcnt(0)" ::: "memory");
            const unsigned og = xb_add(&bar[XB_TOP], 1u);
            const unsigned tg = og / nx;
            if (og + 1u == (tg + 1u) * nx) xb_add(&bar[XB_TOPGEN], 1u);
            else XB_SPIN(xb_ld(&bar[XB_TOPGEN]) == tg, bar);
            __builtin_amdgcn_fence(__ATOMIC_ACQUIRE, "agent");
            xb_add(&bar[XB_XGEN(b.x)], 1u);
            asm volatile("s_waitcnt vmcnt(0)" ::: "memory");
        } else {
            XB_SPIN(xb_ld(&bar[XB_XGEN(b.x)]) == gen, bar);
            __builtin_amdgcn_fence(__ATOMIC_ACQUIRE, "agent");
            asm volatile("s_waitcnt vmcnt(0)" ::: "memory");
        }
    }
    __syncthreads();
}

struct Frame {
    LAS unsigned char* lds;
    int tid, lane, wave, G, vcu;
    float* out; unsigned char* ws;
};
struct Args { const float* in[25]; float* out; unsigned char* ws; int ph_lo, ph_hi; };
constexpr int PO_GSGV = 0, PO_BSGV = 1024, PO_BSG = 2048, PO_BDW = 3072, PO_GCLN = 4096, PO_BCLN = 5120, PO_GFIN = 6144, PO_WDW = 7168, PO_CACHE = PO_WDW + CW * D, PO_END = PO_CACHE + DB * HIST * D;
__device__ __forceinline__ const float* par(const Frame& F, int off) { return (const float*)(F.ws + WS_PAR) + off; }
__device__ __forceinline__ int lane_id() { int l; asm volatile("v_mbcnt_lo_u32_b32 %0, -1, 0\n\tv_mbcnt_hi_u32_b32 %0, -1, %0" : "=v"(l)); return l; }
#define PHASE_IDS(F) do { (F).lane = lane_id(); (F).tid = (F).wave * 64 + (F).lane; } while (0)
__device__ __forceinline__ bf16* wsb(const Frame& F, size_t off) { return (bf16*)(F.ws + off); }
__device__ __forceinline__ bf16* slot(const Frame& F, int i) { return (bf16*)(F.ws + WS_S0 + (size_t)i * SLOT); }
__device__ __forceinline__ float wave_sum(float v) {
#pragma unroll
    for (int o = 1; o < 64; o <<= 1) v += __shfl_xor(v, o);
    return v;
}

__device__ __forceinline__ void tr_item(const float* W, int Nsrc, int K, int k0, int s0, const float* gk, bf16* WT, int d0, LAS float* scr, int lane) {
#pragma unroll 8
    for (int i = 0; i < 32; ++i) { const int kk = 2 * i + (lane >> 5); float v = W[(size_t)(k0 + kk) * Nsrc + s0 + (lane & 31)]; if (gk) v *= gk[k0 + kk]; scr[kk * 33 + (lane & 31)] = v; }
    LDS_WAIT(); asm volatile("" ::: "memory");
    const int c = lane & 7;
#pragma unroll
    for (int j = 0; j < 4; ++j) { const int n = (lane >> 3) + 8 * j; const LAS float* s = scr + (8 * c) * 33 + n;
        u32x4 o; o.x = pk2(s[0 * 33], s[1 * 33]); o.y = pk2(s[2 * 33], s[3 * 33]); o.z = pk2(s[4 * 33], s[5 * 33]); o.w = pk2(s[6 * 33], s[7 * 33]);
        *(u32x4*)(WT + (size_t)(d0 + n) * K + k0 + 8 * c) = o; }
    LDS_WAIT(); asm volatile("" ::: "memory");
}
__device__ __forceinline__ int wr_src_col(int d) {
    if (d < 1024) return d;
    const int base = d < 3072 ? 2048 : 4096, e = d < 3072 ? d - 1024 : d - 3072;
    return base + 1024 * ((e >> 7) & 1) + 128 * (e >> 8) + (e & 127);
}
__device__ __forceinline__ void p0_prologue(Frame& F, const Args& A) {
    LAS float* scr = (LAS float*)(F.lds + RING_OFF + F.wave * 16384);
    const int gw = F.vcu * NWAVES + F.wave, NGW = F.G * NWAVES, lane = F.lane;
    constexpr int I_WR = 16 * 160, I_WV = 16 * 32, I_SQ = 16 * 32, I_UP = 16 * 128, I_DN = 64 * 32, I_PL = 4 * 32;
    constexpr int NITEMS = I_WR + I_WV + 4 * I_SQ + I_UP + I_DN + I_PL;
    for (int it = gw; it < NITEMS; it += NGW) {
        int r = it;
        if (r < I_WR) { const int kb = r / 160, nb = r % 160; tr_item(A.in[6], INC, D, 64 * kb, wr_src_col(32 * nb), nullptr, wsb(F, WS_WR), 32 * nb, scr, lane); continue; } r -= I_WR;
        if (r < I_WV) { const int kb = r / 32, nb = r % 32; tr_item(A.in[6], INC, D, 64 * kb, 1024 + 32 * nb, nullptr, wsb(F, WS_WV), 32 * nb, scr, lane); continue; } r -= I_WV;
        if (r < I_SQ) { const int kb = r / 32, nb = r % 32; tr_item(A.in[11], D, D, 64 * kb, 32 * nb, nullptr, wsb(F, WS_WA), 32 * nb, scr, lane); continue; } r -= I_SQ;
        if (r < I_SQ) { const int kb = r / 32, nb = r % 32; tr_item(A.in[16], D, D, 64 * kb, 32 * nb, nullptr, wsb(F, WS_WB), 32 * nb, scr, lane); continue; } r -= I_SQ;
        if (r < I_SQ) { const int kb = r / 32, nb = r % 32; tr_item(A.in[17], D, D, 64 * kb, 32 * nb, nullptr, wsb(F, WS_WO), 32 * nb, scr, lane); continue; } r -= I_SQ;
        if (r < I_SQ) { const int kb = r / 32, nb = r % 32; tr_item(A.in[22], D, D, 64 * kb, 32 * nb, A.in[21], wsb(F, WS_WPG), 32 * nb, scr, lane); continue; } r -= I_SQ;
        if (r < I_UP) { const int kb = r / 128, nb = r % 128; tr_item(A.in[19], FF, D, 64 * kb, 32 * nb, A.in[18], wsb(F, WS_WUP), 32 * nb, scr, lane); continue; } r -= I_UP;
        if (r < I_DN) { const int kb = r / 32, nb = r % 32; tr_item(A.in[20], D, FF, 64 * kb, 32 * nb, nullptr, wsb(F, WS_WDN), 32 * nb, scr, lane); continue; } r -= I_DN;
        { const int kb = r / 32, nb = r % 32; tr_item(A.in[23], D, PLE, 64 * kb, 32 * nb, nullptr, wsb(F, WS_WPL), 32 * nb, scr, lane); }
    }
    for (int rr = gw; rr < 8 * 128 / 2; rr += NGW) { const int row = 2 * rr + (lane >> 5), t = row & 127, s0 = 4 * (lane & 31);
        const f32x4 w = *(const f32x4*)(A.in[9] + (size_t)row * 128 + s0); u32x2 o;
        o.x = pk2(s0 + 0 <= t ? w.x : 0.f, s0 + 1 <= t ? w.y : 0.f); o.y = pk2(s0 + 2 <= t ? w.z : 0.f, s0 + 3 <= t ? w.w : 0.f);
        *(u32x2*)(wsb(F, WS_WSG) + (size_t)row * 128 + s0) = o; }
    { float* P = (float*)(F.ws + WS_PAR); const int gt = gw * 64 + lane, NT_ = NGW * 64;
      for (int i = gt; i < PO_END / 4; i += NT_) { const int o = 4 * i; const float* src;
          if (o < PO_BSGV) src = A.in[7] + o; else if (o < PO_BSG) src = A.in[8] + (o - PO_BSGV); else if (o < PO_BDW) src = A.in[10] + (o - PO_BSG); else if (o < PO_GCLN) src = A.in[13] + (o - PO_BDW);
          else if (o < PO_BCLN) src = A.in[14] + (o - PO_GCLN); else if (o < PO_GFIN) src = A.in[15] + (o - PO_BCLN); else if (o < PO_WDW) src = A.in[24] + (o - PO_GFIN);
          else if (o < PO_CACHE) src = A.in[12] + (o - PO_WDW); else src = A.in[2] + (o - PO_CACHE);
          *(f32x4*)(P + o) = *(const f32x4*)src; } }
    bf16* XN = slot(F, 0); bf16* PB = wsb(F, WS_PB);
    f32x4 gm[4];
#pragma unroll
    for (int j = 0; j < 4; ++j) gm[j] = *(const f32x4*)(A.in[5] + 4 * lane + 256 * j);
    for (int m = gw; m < M; m += NGW) {
        const float* xr = m < MP ? A.in[0] + (size_t)m * D : A.in[1] + (size_t)(m - MP) * D;
        const float* pr = m < MP ? A.in[3] + (size_t)m * PLE : A.in[4] + (size_t)(m - MP) * PLE;
        f32x4 v[4]; float s = 0.f;
#pragma unroll
        for (int j = 0; j < 4; ++j) { v[j] = *(const f32x4*)(xr + 4 * lane + 256 * j); s += (v[j].x * v[j].x + v[j].y * v[j].y) + (v[j].z * v[j].z + v[j].w * v[j].w); }
        const f32x4 pv = *(const f32x4*)(pr + 4 * lane);
        const float rs = 1.f / sqrtf(wave_sum(s) * (1.f / D) + EPS);
#pragma unroll
        for (int j = 0; j < 4; ++j) { u32x2 o; o.x = pk2(v[j].x * rs * gm[j].x, v[j].y * rs * gm[j].y); o.y = pk2(v[j].z * rs * gm[j].z, v[j].w * rs * gm[j].w);
            *(u32x2*)(XN + (size_t)m * D + 4 * lane + 256 * j) = o; }
        u32x2 po; po.x = pk2(pv.x, pv.y); po.y = pk2(pv.z, pv.w); *(u32x2*)(PB + (size_t)m * PLE + 4 * lane) = po;
    }
}

struct SchedP1 {
    pg8::StaticOrder so;
    __device__ void init(int G, int c) { so.init(MP / 256, 24, G, c); }
    __device__ bool next(int i, pg8::Unit& u) const {
        pg8::Unit v; if (!so.next(i, v)) return false;
        if (v.pn < 20) { u.pm = TP_XN + v.pm; u.pn = TP_WR + v.pn; } else { u.pm = TP_WV + (v.pn - 20); u.pn = TP_XN + v.pm; }
        return true;
    }
};
__device__ __forceinline__ u32x4 pack8(const f32x4 a, const f32x4 b) { u32x4 w; w.x = pk2(a.x, a.y); w.y = pk2(a.z, a.w); w.z = pk2(b.x, b.y); w.w = pk2(b.z, b.w); return w; }
struct EpiP1 {
    static constexpr bool PERM = true, HAS_MID = false;
    bf16 *U, *VT, *C, *RR, *SGB; float *csp, *css;
    __device__ __forceinline__ void mid(f32x4 (&acc)[2][2][4][2], const pg8::Unit& u, int wr, int wc, int, int) const {}
    __device__ __forceinline__ void operator()(const f32x4 (&acc)[2][2][4][2], const pg8::Unit& u, int wr, int wc, int, int) const {
        const int lane_ = lane_id(), fr = lane_ & 15, fq = lane_ >> 4;
        if (u.pm >= TP_WV && u.pm < TP_WV + 4) {
            const int ch0 = (u.pm - TP_WV) * 256 + wr * 64 + fr, tok0 = (u.pn - TP_XN) * 256 + wc * 32 + 8 * fq;
#pragma unroll
            for (int ai = 0; ai < 2; ++ai)
#pragma unroll
                for (int m = 0; m < 4; ++m) { bf16* rowp = VT + (size_t)(ch0 + ai * 128 + m * 16) * M + tok0;
#pragma unroll
                    for (int bj = 0; bj < 2; ++bj) *(u32x4*)(rowp + bj * 128) = pack8(acc[ai][bj][m][0], acc[ai][bj][m][1]); }
            return;
        }
        const int row0 = (u.pm - TP_XN) * 256 + wr * 64 + fr, j = u.pn - TP_WR;
        if (j < 4) {
            const int col0 = j * 256 + wc * 32 + 8 * fq;
#pragma unroll
            for (int ai = 0; ai < 2; ++ai)
#pragma unroll
                for (int m = 0; m < 4; ++m) { bf16* rowp = U + (size_t)(row0 + ai * 128 + m * 16) * D + col0;
#pragma unroll
                    for (int bj = 0; bj < 2; ++bj) *(u32x4*)(rowp + bj * 128) = pack8(acc[ai][bj][m][0], acc[ai][bj][m][1]); }
        } else if (j < 12) {
            const int ch0 = (j - 4) * 128 + wc * 32 + 8 * fq;
#pragma unroll
            for (int ai = 0; ai < 2; ++ai)
#pragma unroll
                for (int m = 0; m < 4; ++m) { const int row = row0 + ai * 128 + m * 16; f32x4 c0, c1;
#pragma unroll
                    for (int e = 0; e < 4; ++e) { c0[e] = acc[ai][0][m][0][e] * sigm(acc[ai][1][m][0][e]); c1[e] = acc[ai][0][m][1][e] * sigm(acc[ai][1][m][1][e]); }
                    *(u32x4*)(C + (size_t)row * D + ch0) = pack8(c0, c1);
                    float* cs = nullptr;
                    if (row < MP) { const int t = row & (SEQ - 1); if (t >= SEQ - HIST) cs = csp + ((size_t)(row >> 12) * HIST + (t - (SEQ - HIST))) * D; }
                    else { const int rr = row - MP, t = rr & (DSEQ - 1); if (t >= DSEQ - HIST) cs = css + ((size_t)(rr >> 5) * HIST + (t - (DSEQ - HIST))) * D; }
                    if (cs) { *(f32x4*)(cs + ch0) = c0; *(f32x4*)(cs + ch0 + 4) = c1; } }
        } else {
            const int ch0 = (j - 12) * 128 + wc * 32 + 8 * fq;
#pragma unroll
            for (int ai = 0; ai < 2; ++ai)
#pragma unroll
                for (int m = 0; m < 4; ++m) { const int row = row0 + ai * 128 + m * 16; f32x4 r0, r1, s0, s1;
#pragma unroll
                    for (int e = 0; e < 4; ++e) {
                        const float ea0 = __expf(-acc[ai][0][m][0][e]), eb0 = __expf(-acc[ai][1][m][0][e]), ea1 = __expf(-acc[ai][0][m][1][e]), eb1 = __expf(-acc[ai][1][m][1][e]);
                        s0[e] = 1.f / (1.f + eb0); s1[e] = 1.f / (1.f + eb1); r0[e] = (1.f + eb0) / (1.f + ea0); r1[e] = (1.f + eb1) / (1.f + ea1); }
                    *(u32x4*)(RR + (size_t)row * D + ch0) = pack8(r0, r1); *(u32x4*)(SGB + (size_t)row * D + ch0) = pack8(s0, s1); }
        }
    }
};

template <int NT>
__device__ __forceinline__ void sg_item(Frame& F, int row0, float* sgv_out) {
    LAS float* red = (LAS float*)(F.lds);
    LAS float* ST = (LAS float*)(F.lds + 8192);
    const bf16* VT = slot(F, 2); const bf16* U = slot(F, 1); bf16* A = slot(F, 0); const bf16* WSG = wsb(F, WS_WSG);
    const int lane = F.lane, wave = F.wave, tid = F.tid;
    __syncthreads();
    {
        constexpr int NO = NT / 8, CS = 64 / NO, NI = 1024 / (CS * 8);
        const int o = lane % NO, cs = lane / NO;
        float s[8], q[8];
#pragma unroll
        for (int j = 0; j < 8; ++j) { s[j] = 0.f; q[j] = 0.f; }
#pragma unroll 4
        for (int i = 0; i < NI; ++i) { const int ch = (i * 8 + wave) * CS + cs; const u32x4 v = *(const u32x4*)(VT + (size_t)ch * M + row0 + 8 * o);
#pragma unroll
            for (int j = 0; j < 4; ++j) { const float lo = bflo(v[j]), hi = bfhi(v[j]); s[2 * j] += lo; q[2 * j] += lo * lo; s[2 * j + 1] += hi; q[2 * j + 1] += hi * hi; } }
#pragma unroll
        for (int off = NO; off < 64; off <<= 1)
#pragma unroll
            for (int j = 0; j < 8; ++j) { s[j] += __shfl_xor(s[j], off); q[j] += __shfl_xor(q[j], off); }
        if (lane < NO)
#pragma unroll
            for (int j = 0; j < 8; ++j) { red[(wave * NT + 8 * o + j) * 2] = s[j]; red[(wave * NT + 8 * o + j) * 2 + 1] = q[j]; }
        __syncthreads();
        if (tid < NT) { float S = 0.f, Q = 0.f;
#pragma unroll
            for (int w = 0; w < 8; ++w) { S += red[(w * NT + tid) * 2]; Q += red[(w * NT + tid) * 2 + 1]; }
            const float mu = S * (1.f / D), var = Q * (1.f / D) - mu * mu; ST[2 * tid] = mu; ST[2 * tid + 1] = 1.f / sqrtf(var + EPS); }
        __syncthreads();
    }
    const int r = lane & 31, h = lane >> 5;
    auto afrag = [&](const bf16* vrow, int ks, float gam, float bet, float* sg_dst) -> bf16x8 {
        const u32x4 v = *(const u32x4*)(vrow + 16 * ks);
        const LAS f32x4* st = (const LAS f32x4*)(ST + 2 * (16 * ks + 8 * h));
        float y[8];
#pragma unroll
        for (int p = 0; p < 4; ++p) { const f32x4 s4 = st[p];
            y[2 * p] = (bflo(v[p]) - s4.x) * (s4.y * gam) + bet; y[2 * p + 1] = (bfhi(v[p]) - s4.z) * (s4.w * gam) + bet; }
        if (sg_dst)
#pragma unroll
            for (int j = 0; j < 8; ++j) sg_dst[(size_t)(16 * ks + 8 * h + j) * D] = y[j];
        u32x4 w; w.x = pk2(y[0], y[1]); w.y = pk2(y[2], y[3]); w.z = pk2(y[4], y[5]); w.w = pk2(y[6], y[7]);
        return __builtin_bit_cast(bf16x8, w);
    };
    auto epi = [&](const f32x16& acc, int g, int cb, int tb) {
        const int t = 32 * tb + r, row = row0 + t; const float bias = par(F, PO_BSG)[g * 128 + t];
#pragma unroll
        for (int eg = 0; eg < 4; ++eg) { const size_t off = (size_t)row * D + g * 128 + cb * 32 + 8 * eg + 4 * h; const u32x2 uu = *(const u32x2*)(U + off);
            u32x2 o; o.x = pk2(bflo(uu.x) * (acc[4 * eg] + bias), bfhi(uu.x) * (acc[4 * eg + 1] + bias)); o.y = pk2(bflo(uu.y) * (acc[4 * eg + 2] + bias), bfhi(uu.y) * (acc[4 * eg + 3] + bias));
            *(u32x2*)(A + off) = o; }
    };
    if constexpr (NT == 128) {
        const int cb = wave & 3, tbA = (wave >> 2) ? 1 : 0, tbB = (wave >> 2) ? 2 : 3, nks = 2 * (tbB + 1), nksA = 2 * (tbA + 1);
        for (int g = 0; g < 8; ++g) {
            const int ch = g * 128 + cb * 32 + r; const float gam = par(F, PO_GSGV)[ch], bet = par(F, PO_BSGV)[ch];
            const bf16* vrow = VT + (size_t)ch * M + row0 + 8 * h;
            const bf16* wA = WSG + ((size_t)g * 128 + 32 * tbA + r) * 128 + 8 * h; const bf16* wB = WSG + ((size_t)g * 128 + 32 * tbB + r) * 128 + 8 * h;
            f32x16 accA, accB;
#pragma unroll
            for (int e = 0; e < 16; ++e) { accA[e] = 0.f; accB[e] = 0.f; }
            for (int ks = 0; ks < nks; ++ks) {
                const bf16x8 a = afrag(vrow, ks, gam, bet, nullptr);
                const bf16x8 bB = *(const bf16x8*)(wB + 16 * ks); accB = __builtin_amdgcn_mfma_f32_32x32x16_bf16(a, bB, accB, 0, 0, 0);
                if (ks < nksA) { const bf16x8 bA = *(const bf16x8*)(wA + 16 * ks); accA = __builtin_amdgcn_mfma_f32_32x32x16_bf16(a, bA, accA, 0, 0, 0); }
            }
            epi(accA, g, cb, tbA); epi(accB, g, cb, tbB);
        }
    } else {
        const int g = wave;
        for (int cb = 0; cb < 4; ++cb) {
            const int ch = g * 128 + cb * 32 + r; const float gam = par(F, PO_GSGV)[ch], bet = par(F, PO_BSGV)[ch];
            const bf16* vrow = VT + (size_t)ch * M + row0 + 8 * h; const bf16* wA = WSG + ((size_t)g * 128 + r) * 128 + 8 * h;
            f32x16 acc;
#pragma unroll
            for (int e = 0; e < 16; ++e) acc[e] = 0.f;
#pragma unroll
            for (int ks = 0; ks < 2; ++ks) { const bf16x8 a = afrag(vrow, ks, gam, bet, sgv_out + ch); const bf16x8 b = *(const bf16x8*)(wA + 16 * ks);
                acc = __builtin_amdgcn_mfma_f32_32x32x16_bf16(a, b, acc, 0, 0, 0); }
            epi(acc, g, cb, 0);
        }
    }
}
template <int NT>
__device__ __forceinline__ void conv_item(Frame& F, int row0, int hist_mode  , const float* cache_b) {
    LAS float* wred = (LAS float*)(F.lds + CW * D * 4);
    LAS float* ST2 = (LAS float*)(F.lds + CW * D * 4 + 1024);
    const bf16* C = slot(F, 3); bf16* BB = slot(F, 6);
    const int tid = F.tid, lane = F.lane, wave = F.wave, c2 = 2 * tid;
    LAS float* wl = (LAS float*)(F.lds);
    __syncthreads();
    { const float* wp = par(F, PO_WDW) + 4 * tid;
#pragma unroll 4
      for (int i = 0; i < (CW * D + 4 * NTHR - 1) / (4 * NTHR); ++i) { if (4 * tid + i * 4 * NTHR < CW * D) *(LAS f32x4*)(wl + 4 * tid + i * 4 * NTHR) = *(const f32x4*)(wp + i * 4 * NTHR); } }
    const f32x2 bd = *(const f32x2*)(par(F, PO_BDW) + c2), gc = *(const f32x2*)(par(F, PO_GCLN) + c2), bc = *(const f32x2*)(par(F, PO_BCLN) + c2);
    __syncthreads();
    f32x2 win[HIST + 8];
#pragma unroll
    for (int i = 0; i < HIST + 8; ++i) win[i] = (f32x2){0.f, 0.f};
    if (hist_mode == 1) {
        const bf16* hp = C + (size_t)(row0 - HIST) * D + c2;
#pragma unroll
        for (int i = 0; i < HIST; ++i) { const unsigned v = *(const unsigned*)hp; win[i] = (f32x2){bflo(v), bfhi(v)}; hp += D; asm volatile("" : "+v"(hp)); }
    } else if (hist_mode == 2) {
        const float* hp = cache_b + c2;
#pragma unroll
        for (int i = 0; i < HIST; ++i) { win[i] = *(const f32x2*)hp; hp += D; asm volatile("" : "+v"(hp)); }
    }
    const bf16* cp = C + (size_t)row0 * D + c2; bf16* op = BB + (size_t)row0 * D + c2;
#pragma clang loop unroll(disable)
    for (int base = 0; base < NT; base += 8) {
        unsigned raw[8];
#pragma unroll
        for (int i = 0; i < 8; ++i) raw[i] = *(const unsigned*)(cp + (size_t)i * D);
        f32x2 dw[8]; float x[16];
#pragma unroll
        for (int i = 0; i < 8; ++i) { win[HIST + i] = (f32x2){bflo(raw[i]), bfhi(raw[i])}; dw[i] = bd; }
#pragma unroll
        for (int j = 0; j < CW; ++j) { const f32x2 wj = *(const LAS f32x2*)(wl + j * D + c2);
#pragma unroll
            for (int i = 0; i < 8; ++i) dw[i] += wj * win[i + j]; }
#pragma unroll
        for (int i = 0; i < 8; ++i) { x[2 * i] = dw[i].x + dw[i].y; x[2 * i + 1] = dw[i].x * dw[i].x + dw[i].y * dw[i].y; }
#pragma unroll
        for (int i = 0; i < HIST; ++i) win[i] = win[i + 8];
#pragma unroll
        for (int st = 0; st < 4; ++st) { const int n = 8 >> st, bit = 32 >> st; const bool up = (lane & bit) != 0;
#pragma unroll
            for (int i = 0; i < n; ++i) { const float keep = up ? x[i + n] : x[i], send = up ? x[i] : x[i + n]; x[i] = keep + __shfl_xor(send, bit); } }
        x[0] += __shfl_xor(x[0], 2); x[0] += __shfl_xor(x[0], 1);
        __syncthreads();
        if ((lane & 3) == 0) wred[wave * 16 + (lane >> 2)] = x[0];
        __syncthreads();
        if (tid < 16) { float tot = 0.f;
#pragma unroll
            for (int wv = 0; wv < 8; ++wv) tot += wred[wv * 16 + tid];
            const float oth = __shfl_xor(tot, 1);
            if ((tid & 1) == 0) { const float mu = tot * (1.f / D), var = oth * (1.f / D) - mu * mu; ST2[tid] = mu; ST2[tid + 1] = 1.f / sqrtf(var + EPS); } }
        __syncthreads();
#pragma unroll
        for (int i = 0; i < 8; ++i) { const f32x2 ms = *(const LAS f32x2*)(ST2 + 2 * i);
            const float y0 = (dw[i].x - ms.x) * ms.y * gc.x + bc.x, y1 = (dw[i].y - ms.x) * ms.y * gc.y + bc.y;
            *(unsigned*)(op + (size_t)i * D) = pk2(y0 * sigm(y0), y1 * sigm(y1)); }
        cp += 8 * D; op += 8 * D;
    }
}
__device__ __forceinline__ void p2_mixers(Frame& F) {
    float* sgv = F.out + (size_t)M * D + 2 * (size_t)DB * HIST * D;
    for (int it = F.vcu; it < 2 * (MP / 128 + DB); it += F.G) {
        if (it < MP / 128) sg_item<128>(F, it * 128, nullptr);
        else if (it < MP / 128 + DB) { const int b = it - MP / 128; sg_item<32>(F, MP + 32 * b, sgv + (size_t)b * DSEQ * D); }
        else if (it < 2 * (MP / 128) + DB) { const int c = it - (MP / 128 + DB); conv_item<128>(F, c * 128, (c & 31) ? 1 : 0, nullptr); }
        else { const int b = it - (2 * (MP / 128) + DB); conv_item<32>(F, MP + 32 * b, 2, par(F, PO_CACHE) + (size_t)b * HIST * D); }
    }
}
struct SchedStd {
    pg8::StaticOrder so;
    __device__ void init(int nM, int nN, int G, int c) { so.init(nM, nN, G, c); }
    __device__ bool next(int i, pg8::Unit& u) const { return so.next(i, u); }
};
__device__ __forceinline__ void mul8(f32x4& a, f32x4& b, const u32x4 w) {
    a.x *= bflo(w.x); a.y *= bfhi(w.x); a.z *= bflo(w.y); a.w *= bfhi(w.y); b.x *= bflo(w.z); b.y *= bfhi(w.z); b.z *= bflo(w.w); b.w *= bfhi(w.w);
}
struct EpiP3 {
    static constexpr bool PERM = true, HAS_MID = true;
    const bf16 *RR, *SGB; bf16* MIX;
    __device__ __forceinline__ void mid(f32x4 (&acc)[2][2][4][2], const pg8::Unit& u, int wr, int wc, int, int) const {
        const int lane_ = lane_id(), fr = lane_ & 15, fq = lane_ >> 4;
        const int row0 = u.pm * 256 + wr * 64 + fr, col0 = u.pn * 256 + wc * 32 + 8 * fq;
#pragma unroll
        for (int ai = 0; ai < 2; ++ai)
#pragma unroll
            for (int m = 0; m < 4; ++m) { const bf16* rowp = RR + (size_t)(row0 + ai * 128 + m * 16) * D + col0;
#pragma unroll
                for (int bj = 0; bj < 2; ++bj) { const u32x4 w = *(const u32x4*)(rowp + bj * 128); mul8(acc[ai][bj][m][0], acc[ai][bj][m][1], w); }
                if (m & 1) asm volatile("" ::: "memory"); }
    }
    __device__ __forceinline__ void operator()(const f32x4 (&acc)[2][2][4][2], const pg8::Unit& u, int wr, int wc, int, int) const {
        const int lane_ = lane_id(), fr = lane_ & 15, fq = lane_ >> 4;
        const int row0 = u.pm * 256 + wr * 64 + fr, col0 = u.pn * 256 + wc * 32 + 8 * fq;
#pragma unroll
        for (int ai = 0; ai < 2; ++ai)
#pragma unroll
            for (int m = 0; m < 4; ++m) { const size_t off = (size_t)(row0 + ai * 128 + m * 16) * D + col0;
#pragma unroll
                for (int bj = 0; bj < 2; ++bj) { const u32x4 w = *(const u32x4*)(SGB + off + bj * 128); f32x4 a = acc[ai][bj][m][0], b = acc[ai][bj][m][1]; mul8(a, b, w);
                    *(u32x4*)(MIX + off + bj * 128) = pack8(a, b); }
                if (m & 1) asm volatile("" ::: "memory"); }
    }
};
struct EpiP4 {
    static constexpr bool PERM = true, HAS_MID = false;
    const float *xp, *xs; float* H; bf16* HB; float* HSS;
    __device__ __forceinline__ void mid(f32x4 (&acc)[2][2][4][2], const pg8::Unit& u, int wr, int wc, int, int) const {}
    __device__ __forceinline__ void operator()(const f32x4 (&acc)[2][2][4][2], const pg8::Unit& u, int wr, int wc, int, int) const {
        const int lane_ = lane_id(), fr = lane_ & 15, fq = lane_ >> 4;
        const int row0 = u.pm * 256 + wr * 64 + fr, col0 = u.pn * 256 + wc * 32 + 8 * fq;
#pragma unroll
        for (int ai = 0; ai < 2; ++ai)
#pragma unroll
            for (int m = 0; m < 4; ++m) { const int row = row0 + ai * 128 + m * 16; const float* xr = (row < MP ? xp + (size_t)row * D : xs + (size_t)(row - MP) * D) + col0; const size_t off = (size_t)row * D + col0; float ss = 0.f;
#pragma unroll
                for (int bj = 0; bj < 2; ++bj) { const f32x4 h0 = *(const f32x4*)(xr + bj * 128) + acc[ai][bj][m][0], h1 = *(const f32x4*)(xr + bj * 128 + 4) + acc[ai][bj][m][1];
                    *(f32x4*)(H + off + bj * 128) = h0; *(f32x4*)(H + off + bj * 128 + 4) = h1; *(u32x4*)(HB + off + bj * 128) = pack8(h0, h1);
                    ss += (h0.x * h0.x + h0.y * h0.y) + (h0.z * h0.z + h0.w * h0.w) + (h1.x * h1.x + h1.y * h1.y) + (h1.z * h1.z + h1.w * h1.w); }
                ss += __shfl_xor(ss, 16); ss += __shfl_xor(ss, 32);
                if (fq == 0) HSS[(size_t)row * 16 + u.pn * 4 + wc] = ss;
                if (m & 1) asm volatile("" ::: "memory"); }
    }
};
struct EpiP5 {
    static constexpr bool PERM = true, HAS_MID = false;
    bf16* ACT;
    __device__ __forceinline__ void mid(f32x4 (&acc)[2][2][4][2], const pg8::Unit& u, int wr, int wc, int, int) const {}
    __device__ __forceinline__ void operator()(const f32x4 (&acc)[2][2][4][2], const pg8::Unit& u, int wr, int wc, int, int) const {
        const int lane_ = lane_id(), fr = lane_ & 15, fq = lane_ >> 4;
        const int row0 = u.pm * 256 + wr * 64 + fr, col0 = u.pn * 256 + wc * 32 + 8 * fq;
#pragma unroll
        for (int ai = 0; ai < 2; ++ai)
#pragma unroll
            for (int m = 0; m < 4; ++m) { bf16* rowp = ACT + (size_t)(row0 + ai * 128 + m * 16) * FF + col0;
#pragma unroll
                for (int bj = 0; bj < 2; ++bj) { f32x4 a = acc[ai][bj][m][0], b = acc[ai][bj][m][1];
#pragma unroll
                    for (int e = 0; e < 4; ++e) { const float ra = a[e] > 0.f ? a[e] : 0.f, rb = b[e] > 0.f ? b[e] : 0.f; a[e] = ra * ra; b[e] = rb * rb; }
                    *(u32x4*)(rowp + bj * 128) = pack8(a, b); } }
    }
};
__device__ __forceinline__ float row_ss16(const float* p) {
    const f32x4 a = *(const f32x4*)p, b = *(const f32x4*)(p + 4), c = *(const f32x4*)(p + 8), d = *(const f32x4*)(p + 12);
    return ((a.x + a.y) + (a.z + a.w)) + ((b.x + b.y) + (b.z + b.w)) + ((c.x + c.y) + (c.z + c.w)) + ((d.x + d.y) + (d.z + d.w));
}
struct EpiP6 {
    static constexpr bool PERM = true, HAS_MID = false;
    float* H; bf16* HB; const float* HSS1; float* HSS2;
    __device__ __forceinline__ void mid(f32x4 (&acc)[2][2][4][2], const pg8::Unit& u, int wr, int wc, int, int) const {}
    __device__ __forceinline__ void operator()(const f32x4 (&acc)[2][2][4][2], const pg8::Unit& u, int wr, int wc, int, int) const {
        const int lane_ = lane_id(), fr = lane_ & 15, fq = lane_ >> 4;
        const int row0 = u.pm * 256 + wr * 64 + fr, col0 = u.pn * 256 + wc * 32 + 8 * fq;
#pragma unroll
        for (int ai = 0; ai < 2; ++ai)
#pragma unroll
            for (int m = 0; m < 4; ++m) { const int row = row0 + ai * 128 + m * 16; const size_t off = (size_t)row * D + col0; float ss = 0.f;
                const float rinv = 1.f / (row_ss16(HSS1 + (size_t)row * 16) * (1.f / D) + EPS);
#pragma unroll
                for (int bj = 0; bj < 2; ++bj) { const f32x4 h0 = *(const f32x4*)(H + off + bj * 128) + acc[ai][bj][m][0] * rinv, h1 = *(const f32x4*)(H + off + bj * 128 + 4) + acc[ai][bj][m][1] * rinv;
                    *(f32x4*)(H + off + bj * 128) = h0; *(f32x4*)(H + off + bj * 128 + 4) = h1; *(u32x4*)(HB + off + bj * 128) = pack8(h0, h1);
                    ss += (h0.x * h0.x + h0.y * h0.y) + (h0.z * h0.z + h0.w * h0.w) + (h1.x * h1.x + h1.y * h1.y) + (h1.z * h1.z + h1.w * h1.w); }
                ss += __shfl_xor(ss, 16); ss += __shfl_xor(ss, 32);
                if (fq == 0) HSS2[(size_t)row * 16 + u.pn * 4 + wc] = ss;
                if (m & 1) asm volatile("" ::: "memory"); }
    }
};
struct EpiP7 {
    static constexpr bool PERM = true, HAS_MID = true;
    float* H; bf16* PE; const float* HSS2;
    __device__ __forceinline__ void mid(f32x4 (&acc)[2][2][4][2], const pg8::Unit& u, int wr, int wc, int, int) const {
        const int lane_ = lane_id(), fr = lane_ & 15, fq = lane_ >> 4;
        const int row0 = u.pm * 256 + wr * 64 + fr, col0 = u.pn * 256 + wc * 32 + 8 * fq;
#pragma unroll
        for (int ai = 0; ai < 2; ++ai)
#pragma unroll
            for (int m = 0; m < 4; ++m) { bf16* rowp = PE + (size_t)(row0 + ai * 128 + m * 16) * D + col0;
#pragma unroll
                for (int bj = 0; bj < 2; ++bj) { *(u32x4*)(rowp + bj * 128) = pack8(acc[ai][bj][m][0], acc[ai][bj][m][1]); acc[ai][bj][m][0] = (f32x4){0.f, 0.f, 0.f, 0.f}; acc[ai][bj][m][1] = (f32x4){0.f, 0.f, 0.f, 0.f}; } }
    }
    __device__ __forceinline__ void operator()(const f32x4 (&acc)[2][2][4][2], const pg8::Unit& u, int wr, int wc, int, int) const {
        const int lane_ = lane_id(), fr = lane_ & 15, fq = lane_ >> 4;
        const int row0 = u.pm * 256 + wr * 64 + fr, col0 = u.pn * 256 + wc * 32 + 8 * fq;
#pragma unroll
        for (int ai = 0; ai < 2; ++ai)
#pragma unroll
            for (int m = 0; m < 4; ++m) { const int row = row0 + ai * 128 + m * 16; const size_t off = (size_t)row * D + col0;
                const float rs = 1.f / sqrtf(row_ss16(HSS2 + (size_t)row * 16) * (1.f / D) + EPS);
#pragma unroll
                for (int bj = 0; bj < 2; ++bj) { const u32x4 w = *(const u32x4*)(PE + off + bj * 128); f32x4 g0, g1;
#pragma unroll
                    for (int e = 0; e < 4; ++e) { g0[e] = sigm(rs * acc[ai][bj][m][0][e]); g1[e] = sigm(rs * acc[ai][bj][m][1][e]); }
                    mul8(g0, g1, w);
                    *(f32x4*)(H + off + bj * 128) = *(const f32x4*)(H + off + bj * 128) + g0; *(f32x4*)(H + off + bj * 128 + 4) = *(const f32x4*)(H + off + bj * 128 + 4) + g1; }
                asm volatile("" ::: "memory"); }
    }
};
constexpr int PO_SS1 = PO_END, PO_SS2 = PO_END + 256 * 32;
static_assert((size_t)(PO_SS2 + 256 * 32) * 4 <= WS_END - WS_PAR, "PAR region");
template <int NSEG, class Epi>
__device__ __forceinline__ void skinny_tile(Frame& F, const bf16* A0, int lda0, const bf16* B0, int ldb0, int K0, const bf16* A1, int lda1, const bf16* B1, int ldb1, int K1, const Epi& epi) {
    LAS float* red = (LAS float*)F.lds;
    const int lane = F.lane, wave = F.wave, r = lane & 31, h = lane >> 5;
    f32x16 acc0, acc1;
#pragma unroll
    for (int e = 0; e < 16; ++e) { acc0[e] = 0.f; acc1[e] = 0.f; }
    { const int kw = K0 >> 3; const bf16* ap = A0 + (size_t)r * lda0 + wave * kw + 8 * h; const bf16* bp = B0 + (size_t)r * ldb0 + wave * kw + 8 * h;
#pragma unroll 4
      for (int k = 0; k < kw; k += 16) { const bf16x8 a = *(const bf16x8*)(ap + k), b = *(const bf16x8*)(bp + k); acc0 = __builtin_amdgcn_mfma_f32_32x32x16_bf16(a, b, acc0, 0, 0, 0); } }
    if constexpr (NSEG == 2) { const int kw = K1 >> 3; const bf16* ap = A1 + (size_t)r * lda1 + wave * kw + 8 * h; const bf16* bp = B1 + (size_t)r * ldb1 + wave * kw + 8 * h;
#pragma unroll 4
      for (int k = 0; k < kw; k += 16) { const bf16x8 a = *(const bf16x8*)(ap + k), b = *(const bf16x8*)(bp + k); acc1 = __builtin_amdgcn_mfma_f32_32x32x16_bf16(a, b, acc1, 0, 0, 0); } }
#pragma unroll
    for (int e = 0; e < 16; ++e) { const int row = (e & 3) + 8 * (e >> 2) + 4 * h; red[(wave * NSEG) * 1024 + row * 32 + r] = acc0[e]; if constexpr (NSEG == 2) red[(wave * NSEG + 1) * 1024 + row * 32 + r] = acc1[e]; }
    __syncthreads();
    const int row = F.tid >> 4, c0 = 2 * (F.tid & 15);
    float p[2] = {0.f, 0.f}, q[2] = {0.f, 0.f};
#pragma unroll
    for (int w = 0; w < 8; ++w) { const f32x2 t = *(const LAS f32x2*)(red + (w * NSEG) * 1024 + row * 32 + c0); p[0] += t.x; p[1] += t.y;
        if constexpr (NSEG == 2) { const f32x2 t2 = *(const LAS f32x2*)(red + (w * NSEG + 1) * 1024 + row * 32 + c0); q[0] += t2.x; q[1] += t2.y; } }
    epi(row, c0, p, q);
    __syncthreads();
}
__device__ __forceinline__ float sum16(float v) { v += __shfl_xor(v, 1); v += __shfl_xor(v, 2); v += __shfl_xor(v, 4); v += __shfl_xor(v, 8); return v; }
__device__ __forceinline__ float ss_row32(const float* p) { float s = 0.f;
#pragma unroll
    for (int i = 0; i < 32; ++i) s += p[i * 256]; return s; }
__device__ __forceinline__ void s1_sample(Frame& F) {
    const bf16* XN = slot(F, 0); const bf16* WR = wsb(F, WS_WR); const bf16* WV = wsb(F, WS_WV);
    bf16 *U = slot(F, 1), *VT = slot(F, 2), *C = slot(F, 3), *RR = slot(F, 4), *SGB = slot(F, 5); float* css = F.out + (size_t)M * D + (size_t)DB * HIST * D;
    for (int u = F.vcu; u < 8 * 128; u += F.G) {
        const int rb = u & 7, blk = u >> 3, type = blk >> 5, jb = blk & 31, row0 = MP + 32 * rb; const bf16* A = XN + (size_t)row0 * D;
        if (type == 0) skinny_tile<1>(F, A, D, WR + (size_t)(32 * jb) * D, D, D, A, D, WR, D, D, [&](int row, int c0, const float* p, const float*) {
            *(unsigned*)(U + (size_t)(row0 + row) * D + 32 * jb + c0) = pk2(p[0], p[1]); });
        else if (type == 1) skinny_tile<1>(F, A, D, WV + (size_t)(32 * jb) * D, D, D, A, D, WV, D, D, [&](int row, int c0, const float* p, const float*) {
            VT[(size_t)(32 * jb + c0) * M + row0 + row] = (bf16)f2bf(p[0]); VT[(size_t)(32 * jb + c0 + 1) * M + row0 + row] = (bf16)f2bf(p[1]); });
        else { const int wrow = (type == 2 ? 1024 : 3072) + 256 * (jb >> 2) + 32 * (jb & 3);
            const bf16* Ba = WR + (size_t)wrow * D; const bf16* Bb = Ba + (size_t)128 * D;
            if (type == 2) skinny_tile<2>(F, A, D, Ba, D, D, A, D, Bb, D, D, [&](int row, int c0, const float* p, const float* q) {
                const float v0 = p[0] * sigm(q[0]), v1 = p[1] * sigm(q[1]); const int t = row;
                *(unsigned*)(C + (size_t)(row0 + row) * D + 32 * jb + c0) = pk2(v0, v1);
                if (t >= DSEQ - HIST) *(f32x2*)(css + ((size_t)rb * HIST + (t - (DSEQ - HIST))) * D + 32 * jb + c0) = (f32x2){v0, v1}; });
            else skinny_tile<2>(F, A, D, Ba, D, D, A, D, Bb, D, D, [&](int row, int c0, const float* p, const float* q) {
                const float ea0 = __expf(-p[0]), ea1 = __expf(-p[1]), eb0 = __expf(-q[0]), eb1 = __expf(-q[1]); const size_t off = (size_t)(row0 + row) * D + 32 * jb + c0;
                *(unsigned*)(RR + off) = pk2((1.f + eb0) / (1.f + ea0), (1.f + eb1) / (1.f + ea1)); *(unsigned*)(SGB + off) = pk2(1.f / (1.f + eb0), 1.f / (1.f + eb1)); }); }
    }
}
__device__ __forceinline__ void s3_sample(Frame& F) {
    const bf16 *A = slot(F, 0), *BB = slot(F, 6), *RR = slot(F, 4), *SGB = slot(F, 5); bf16* MIX = slot(F, 1);
    for (int u = F.vcu; u < 8 * 32; u += F.G) { const int rb = u & 7, jb = u >> 3, row0 = MP + 32 * rb;
        skinny_tile<2>(F, A + (size_t)row0 * D, D, wsb(F, WS_WA) + (size_t)(32 * jb) * D, D, D, BB + (size_t)row0 * D, D, wsb(F, WS_WB) + (size_t)(32 * jb) * D, D, D, [&](int row, int c0, const float* p, const float* q) {
            const size_t off = (size_t)(row0 + row) * D + 32 * jb + c0; const unsigned rr = *(const unsigned*)(RR + off), sg = *(const unsigned*)(SGB + off);
            *(unsigned*)(MIX + off) = pk2(bflo(sg) * (bflo(rr) * p[0] + q[0]), bfhi(sg) * (bfhi(rr) * p[1] + q[1])); }); }
}
__device__ __forceinline__ void s4_sample(Frame& F, const float* xs) {
    const bf16* MIX = slot(F, 1); bf16* HB = slot(F, 2); float* SS1 = (float*)(F.ws + WS_PAR) + PO_SS1;
    for (int u = F.vcu; u < 8 * 32; u += F.G) { const int rb = u & 7, jb = u >> 3, row0 = MP + 32 * rb;
        skinny_tile<1>(F, MIX + (size_t)row0 * D, D, wsb(F, WS_WO) + (size_t)(32 * jb) * D, D, D, MIX, D, MIX, D, D, [&](int row, int c0, const float* p, const float*) {
            const size_t off = (size_t)(row0 + row) * D + 32 * jb + c0; const f32x2 x = *(const f32x2*)(xs + (size_t)(32 * rb + row) * D + 32 * jb + c0);
            const float h0 = x.x + p[0], h1 = x.y + p[1]; *(f32x2*)(F.out + off) = (f32x2){h0, h1}; *(unsigned*)(HB + off) = pk2(h0, h1);
            const float ss = sum16(h0 * h0 + h1 * h1); if ((F.tid & 15) == 0) SS1[jb * 256 + 32 * rb + row] = ss; }); }
}
__device__ __forceinline__ void s5_sample(Frame& F) {
    const bf16* HB = slot(F, 2); bf16* ACT = slot(F, 3);
    for (int u = F.vcu; u < 8 * 128; u += F.G) { const int rb = u & 7, jb = u >> 3, row0 = MP + 32 * rb;
        skinny_tile<1>(F, HB + (size_t)row0 * D, D, wsb(F, WS_WUP) + (size_t)(32 * jb) * D, D, D, HB, D, HB, D, D, [&](int row, int c0, const float* p, const float*) {
            const float a = p[0] > 0.f ? p[0] : 0.f, b = p[1] > 0.f ? p[1] : 0.f; *(unsigned*)(ACT + (size_t)(row0 + row) * FF + 32 * jb + c0) = pk2(a * a, b * b); }); }
}
__device__ __forceinline__ void s6_sample(Frame& F) {
    const bf16* ACT = slot(F, 3); bf16* HB2 = slot(F, 0); const float* SS1 = (const float*)(F.ws + WS_PAR) + PO_SS1; float* SS2 = (float*)(F.ws + WS_PAR) + PO_SS2;
    for (int u = F.vcu; u < 8 * 32; u += F.G) { const int rb = u & 7, jb = u >> 3, row0 = MP + 32 * rb;
        skinny_tile<1>(F, ACT + (size_t)row0 * FF, FF, wsb(F, WS_WDN) + (size_t)(32 * jb) * FF, FF, FF, ACT, FF, ACT, FF, FF, [&](int row, int c0, const float* p, const float*) {
            const size_t off = (size_t)(row0 + row) * D + 32 * jb + c0; const float rinv = 1.f / (ss_row32(SS1 + 32 * rb + row) * (1.f / D) + EPS);
            const f32x2 hh = *(const f32x2*)(F.out + off); const float h0 = hh.x + rinv * p[0], h1 = hh.y + rinv * p[1];
            *(f32x2*)(F.out + off) = (f32x2){h0, h1}; *(unsigned*)(HB2 + off) = pk2(h0, h1);
            const float ss = sum16(h0 * h0 + h1 * h1); if ((F.tid & 15) == 0) SS2[jb * 256 + 32 * rb + row] = ss; }); }
}
__device__ __forceinline__ void s7_sample(Frame& F) {
    const bf16* HB2 = slot(F, 0); const bf16* PB = wsb(F, WS_PB); const float* SS2 = (const float*)(F.ws + WS_PAR) + PO_SS2;
    for (int u = F.vcu; u < 8 * 32; u += F.G) { const int rb = u & 7, jb = u >> 3, row0 = MP + 32 * rb;
        skinny_tile<2>(F, PB + (size_t)row0 * PLE, PLE, wsb(F, WS_WPL) + (size_t)(32 * jb) * PLE, PLE, PLE, HB2 + (size_t)row0 * D, D, wsb(F, WS_WPG) + (size_t)(32 * jb) * D, D, D, [&](int row, int c0, const float* p, const float* q) {
            const size_t off = (size_t)(row0 + row) * D + 32 * jb + c0; const float rs = 1.f / sqrtf(ss_row32(SS2 + 32 * rb + row) * (1.f / D) + EPS);
            const f32x2 hh = *(const f32x2*)(F.out + off); *(f32x2*)(F.out + off) = (f32x2){hh.x + sigm(rs * q[0]) * p[0], hh.y + sigm(rs * q[1]) * p[1]}; }); }
}
__device__ __forceinline__ void p8_final(Frame& F) {
    const int gw = F.vcu * NWAVES + F.wave, NGW = F.G * NWAVES, lane = F.lane;
    f32x4 gf[4];
#pragma unroll
    for (int j = 0; j < 4; ++j) gf[j] = *(const f32x4*)(par(F, PO_GFIN) + 4 * lane + 256 * j);
    for (int m = gw; m < M; m += NGW) { float* xr = F.out + (size_t)m * D + 4 * lane; f32x4 v[4]; float s = 0.f;
#pragma unroll
        for (int j = 0; j < 4; ++j) { v[j] = *(const f32x4*)(xr + 256 * j); s += (v[j].x * v[j].x + v[j].y * v[j].y) + (v[j].z * v[j].z + v[j].w * v[j].w); }
        const float rs = 1.f / sqrtf(wave_sum(s) * (1.f / D) + EPS);
#pragma unroll
        for (int j = 0; j < 4; ++j) *(f32x4*)(xr + 256 * j) = v[j] * rs * gf[j]; }
}

constexpr int N_PHASES = 9;
__global__ void __launch_bounds__(NTHR, 2) mega_fwd(Args args) {
    extern __shared__ __attribute__((aligned(16))) unsigned char lds[];
    Frame F;
    F.lds = (LAS unsigned char*)lds;
    F.wave = __builtin_amdgcn_readfirstlane((int)threadIdx.x >> 6); PHASE_IDS(F);
    F.G = gridDim.x; { const int bx = blockIdx.x; F.vcu = (F.G % 8 == 0) ? (bx % 8) * (F.G / 8) + bx / 8 : bx; }
    F.out = args.out; F.ws = args.ws;
    volatile LAS unsigned* MISC = (volatile LAS unsigned*)(F.lds + MISC_OFF);
    for (int u = F.tid; u < (LDS_BYTES - LDSCTL_OFF) / 4; u += NTHR) ((LAS unsigned*)(F.lds + LDSCTL_OFF))[u] = 0u;
    __syncthreads();
    const int lo = args.ph_lo, hi = args.ph_hi;
    XcdBarrier bar; bar.bar = (unsigned*)(F.ws + WS_CTL) + CW_BAR; bar.x = 0; bar.st = nullptr;
    if (hi - lo > 1) bar = xcd_barrier_post((unsigned*)(F.ws + WS_CTL) + CW_BAR, MISC + 8, F.wave == 0 && F.lane == 0);
#ifndef PHASE_MASK
#define PHASE_MASK 0x1ff
#endif
#define IN(k) (((PHASE_MASK >> (k)) & 1) && lo <= (k) && (k) < hi)
#define SEAM(k) do { if (IN(k) && IN((k) + 1)) xcd_barrier(bar, F.wave == 0 && lane_id() == 0); } while (0)
    float* csp = F.out + (size_t)M * D; float* css = csp + (size_t)DB * HIST * D;
    float* HSS1 = (float*)(F.ws + WS_HSS1); float* HSS2 = (float*)(F.ws + WS_HSS2);
    const char* wbase = (const char*)(F.ws + WS_WR);

    if (IN(0)) { PHASE_IDS(F); p0_prologue(F, args); SEAM(0); }
    if (IN(1)) {
        pg8::Gemm g{wbase, wbase, wbase, wbase, D, D, D, D, 16, 16}; SchedP1 S; S.init(F.G, (int)blockIdx.x);
        EpiP1 E{slot(F, 1), slot(F, 2), slot(F, 3), slot(F, 4), slot(F, 5), csp, css};
        PHASE_IDS(F); pg8::gemm_phase<EpiP1, SchedP1>(F.lds + RING_OFF, g, S, E, F.tid);
        PHASE_IDS(F); s1_sample(F);
        SEAM(1);
    }
    if (IN(2)) { PHASE_IDS(F); p2_mixers(F); SEAM(2); }
    if (IN(3)) {
        pg8::Gemm g{(const char*)slot(F, 0), (const char*)slot(F, 6), (const char*)(F.ws + WS_WA), (const char*)(F.ws + WS_WB), D, D, D, D, 32, 16}; SchedStd S; S.init(MP / 256, 4, F.G, (int)blockIdx.x);
        EpiP3 E{slot(F, 4), slot(F, 5), slot(F, 1)};
        PHASE_IDS(F); pg8::gemm_phase<EpiP3, SchedStd>(F.lds + RING_OFF, g, S, E, F.tid);
        PHASE_IDS(F); s3_sample(F);
        SEAM(3);
    }
    if (IN(4)) {
        const char* a = (const char*)slot(F, 1); const char* b = (const char*)(F.ws + WS_WO);
        pg8::Gemm g{a, a, b, b, D, D, D, D, 16, 16}; SchedStd S; S.init(MP / 256, 4, F.G, (int)blockIdx.x);
        EpiP4 E{args.in[0], args.in[1], F.out, slot(F, 2), HSS1};
        PHASE_IDS(F); pg8::gemm_phase<EpiP4, SchedStd>(F.lds + RING_OFF, g, S, E, F.tid);
        PHASE_IDS(F); s4_sample(F, args.in[1]);
        SEAM(4);
    }
    if (IN(5)) {
        const char* a = (const char*)slot(F, 2); const char* b = (const char*)(F.ws + WS_WUP);
        pg8::Gemm g{a, a, b, b, D, D, D, D, 16, 16}; SchedStd S; S.init(MP / 256, FF / 256, F.G, (int)blockIdx.x);
        EpiP5 E{slot(F, 3)};
        PHASE_IDS(F); pg8::gemm_phase<EpiP5, SchedStd>(F.lds + RING_OFF, g, S, E, F.tid);
        PHASE_IDS(F); s5_sample(F);
        SEAM(5);
    }
    if (IN(6)) {
        const char* a = (const char*)slot(F, 3); const char* b = (const char*)(F.ws + WS_WDN);
        pg8::Gemm g{a, a, b, b, FF, FF, FF, FF, 64, 64}; SchedStd S; S.init(MP / 256, 4, F.G, (int)blockIdx.x);
        EpiP6 E{F.out, slot(F, 0), HSS1, HSS2};
        PHASE_IDS(F); pg8::gemm_phase<EpiP6, SchedStd>(F.lds + RING_OFF, g, S, E, F.tid);
        PHASE_IDS(F); s6_sample(F);
        SEAM(6);
    }
    if (IN(7)) {
        pg8::Gemm g{(const char*)(F.ws + WS_PB), (const char*)slot(F, 0), (const char*)(F.ws + WS_WPL), (const char*)(F.ws + WS_WPG), PLE, D, PLE, D, 20, 4}; SchedStd S; S.init(MP / 256, 4, F.G, (int)blockIdx.x);
        EpiP7 E{F.out, slot(F, 1), HSS2};
        PHASE_IDS(F); pg8::gemm_phase<EpiP7, SchedStd, true>(F.lds + RING_OFF, g, S, E, F.tid);
        PHASE_IDS(F); s7_sample(F);
        SEAM(7);
    }
    if (IN(8)) { PHASE_IDS(F); p8_final(F); }
#undef IN
#undef SEAM
}
#ifndef MEGA_HI
#define MEGA_HI 9
#endif
#ifndef ONE_LAUNCH
#define ONE_LAUNCH 1
#endif
#if MEGA_HI < 9
__device__ __forceinline__ float block_sum256(float v, float* sh) {
    for (int o = 1; o < 64; o <<= 1) v += __shfl_xor(v, o);
    __syncthreads(); if ((threadIdx.x & 63) == 0) sh[threadIdx.x >> 6] = v; __syncthreads();
    return sh[0] + sh[1] + sh[2] + sh[3];
}
__global__ void k_rms(const float* __restrict__ X, bf16* __restrict__ O) {
    __shared__ float sh[4];
    const int row = blockIdx.x; const float* x = X + (size_t)row * D; float v[4]; float s = 0.f;
    for (int i = 0; i < 4; ++i) { v[i] = x[threadIdx.x + 256 * i]; s += v[i] * v[i]; }
    s = block_sum256(s, sh); const float rs = 1.f / sqrtf(s / D + EPS);
    for (int i = 0; i < 4; ++i) O[(size_t)row * D + threadIdx.x + 256 * i] = (bf16)f2bf(v[i] * rs);
}
__global__ void k_final(float* __restrict__ H, const float* __restrict__ g) {
    __shared__ float sh[4];
    float* x = H + (size_t)blockIdx.x * D; float v[4]; float s = 0.f;
    for (int i = 0; i < 4; ++i) { v[i] = x[threadIdx.x + 256 * i]; s += v[i] * v[i]; }
    s = block_sum256(s, sh); const float rs = 1.f / sqrtf(s / D + EPS);
    for (int i = 0; i < 4; ++i) x[threadIdx.x + 256 * i] = v[i] * rs * g[threadIdx.x + 256 * i];
}
template <class Epi>
__global__ void __launch_bounds__(256) k_gemm(const bf16* __restrict__ A, int lda, const bf16* __restrict__ Bt, int ldb, int K, Epi epi) {
    const int wave = threadIdx.x >> 6, lane = threadIdx.x & 63, r = lane & 31, h = lane >> 5;
    const int row0 = blockIdx.y * 128 + (wave >> 1) * 64, col0 = blockIdx.x * 128 + (wave & 1) * 64;
    f32x16 acc[2][2];
    for (int i = 0; i < 2; ++i) for (int j = 0; j < 2; ++j) for (int e = 0; e < 16; ++e) acc[i][j][e] = 0.f;
    const bf16* ap = A + (size_t)(row0 + r) * lda + 8 * h; const bf16* bp = Bt + (size_t)(col0 + r) * ldb + 8 * h;
    for (int k0 = 0; k0 < K; k0 += 16) {
        bf16x8 a[2], b[2];
        for (int i = 0; i < 2; ++i) { a[i] = *(const bf16x8*)(ap + (size_t)32 * i * lda + k0); b[i] = *(const bf16x8*)(bp + (size_t)32 * i * ldb + k0); }
        for (int i = 0; i < 2; ++i) for (int j = 0; j < 2; ++j) acc[i][j] = __builtin_amdgcn_mfma_f32_32x32x16_bf16(a[i], b[j], acc[i][j], 0, 0, 0);
    }
    for (int i = 0; i < 2; ++i) for (int j = 0; j < 2; ++j) for (int e = 0; e < 16; ++e)
        epi(row0 + 32 * i + (e & 3) + 8 * (e >> 2) + 4 * h, col0 + 32 * j + r, acc[i][j][e]);
}
struct E3a { const bf16* RR; bf16* T; __device__ void operator()(int row, int col, float v) const { size_t i = (size_t)row * D + col; T[i] = (bf16)f2bf(bf2f(RR[i]) * v); } };
struct E3b { const bf16* SGB; const bf16* T; bf16* MIX; __device__ void operator()(int row, int col, float v) const { size_t i = (size_t)row * D + col; MIX[i] = (bf16)f2bf(bf2f(SGB[i]) * (bf2f(T[i]) + v)); } };
struct E4 { const float* xa; const float* xb; float* H; __device__ void operator()(int row, int col, float v) const {
    const float x = row < MP ? xa[(size_t)row * D + col] : xb[(size_t)(row - MP) * D + col]; H[(size_t)row * D + col] = x + v; } };
struct E5 { bf16* ACT; __device__ void operator()(int row, int col, float v) const { const float r = v > 0.f ? v : 0.f; ACT[(size_t)row * FF + col] = (bf16)f2bf(r * r); } };
struct E6 { float* H; __device__ void operator()(int row, int col, float v) const { H[(size_t)row * D + col] += v; } };
struct E7a { bf16* PE; __device__ void operator()(int row, int col, float v) const { PE[(size_t)row * D + col] = (bf16)f2bf(v); } };
struct E7b { const bf16* PE; float* H; __device__ void operator()(int row, int col, float v) const { size_t i = (size_t)row * D + col; H[i] += sigm(v) * bf2f(PE[i]); } };
#endif

extern "C" void kernel_launch(void* const* d_in, const int* in_sizes, int n_in, void* d_out, int out_size, void* d_ws, size_t ws_size, hipStream_t stream) {
    static int grid = 0;
    if (grid == 0) {
        if (n_in != 25 || in_sizes[0] != MP * D || out_size != M * D + 2 * DB * HIST * D + MS * D || ws_size < WS_END) {
            fprintf(stderr, "kernel_launch: unexpected shapes: n_in %d, in0 %d, out %d, ws %zu (need %zu); nothing launched\n", n_in, n_in > 0 ? in_sizes[0] : -1, out_size, ws_size, (size_t)WS_END); grid = -1; return; }
        int dev = 0, cus = 0, per_cu = 0;
        if (hipGetDevice(&dev) != hipSuccess || hipDeviceGetAttribute(&cus, hipDeviceAttributeMultiprocessorCount, dev) != hipSuccess) { fprintf(stderr, "kernel_launch: device query failed\n"); grid = -1; return; }
        if (hipFuncSetAttribute((const void*)mega_fwd, hipFuncAttributeMaxDynamicSharedMemorySize, LDS_BYTES) != hipSuccess) { fprintf(stderr, "kernel_launch: hipFuncSetAttribute failed\n"); grid = -1; return; }
        if (hipOccupancyMaxActiveBlocksPerMultiprocessor(&per_cu, (const void*)mega_fwd, NTHR, LDS_BYTES) != hipSuccess || per_cu < 1)
            fprintf(stderr, "kernel_launch: note: occupancy query reports %d workgroups per CU\n", per_cu);
        (void)hipGetLastError();
        grid = cus;
    }
    if (grid < 0) return;
    if (hipMemsetAsync((char*)d_ws + WS_CTL, 0, CTL_ZERO_BYTES, stream) != hipSuccess) { fprintf(stderr, "kernel_launch: memset failed\n"); return; }
    Args a{};
    for (int i = 0; i < 25; ++i) a.in[i] = (const float*)d_in[i];
    a.out = (float*)d_out; a.ws = (unsigned char*)d_ws;
#if ONE_LAUNCH
    a.ph_lo = 0; a.ph_hi = MEGA_HI;
    hipLaunchKernelGGL(mega_fwd, dim3(grid), dim3(NTHR), LDS_BYTES, stream, a);
#else
    for (int ph = 0; ph < MEGA_HI; ++ph) { a.ph_lo = ph; a.ph_hi = ph + 1; hipLaunchKernelGGL(mega_fwd, dim3(grid), dim3(NTHR), LDS_BYTES, stream, a); }
#endif
    { const hipError_t le = hipPeekAtLastError(); if (le != hipSuccess) fprintf(stderr, "kernel_launch: launch failed: %s\n", hipGetErrorName(le)); }
#if MEGA_HI < 9
    char* ws = (char*)d_ws; float* H = (float*)d_out;
    auto S = [&](int i) { return (bf16*)(ws + WS_S0 + (size_t)i * SLOT); };
    const float* x_p = (const float*)d_in[0]; const float* x_s = (const float*)d_in[1];
    if (MEGA_HI <= 3) {
        k_gemm<E3a><<<dim3(D / 128, M / 128), 256, 0, stream>>>(S(0), D, (const bf16*)(ws + WS_WA), D, D, E3a{S(4), S(2)});
        k_gemm<E3b><<<dim3(D / 128, M / 128), 256, 0, stream>>>(S(6), D, (const bf16*)(ws + WS_WB), D, D, E3b{S(5), S(2), S(1)});
    }
    if (MEGA_HI <= 4) k_gemm<E4><<<dim3(D / 128, M / 128), 256, 0, stream>>>(S(1), D, (const bf16*)(ws + WS_WO), D, D, E4{x_p, x_s, H});
    if (MEGA_HI <= 5) {
        k_rms<<<M, 256, 0, stream>>>(H, S(2));
        k_gemm<E5><<<dim3(FF / 128, M / 128), 256, 0, stream>>>(S(2), D, (const bf16*)(ws + WS_WUP), D, D, E5{S(3)});
        k_gemm<E6><<<dim3(D / 128, M / 128), 256, 0, stream>>>(S(3), FF, (const bf16*)(ws + WS_WDN), FF, FF, E6{H});
    }
    if (MEGA_HI <= 7) {
        k_rms<<<M, 256, 0, stream>>>(H, S(0));
        k_gemm<E7a><<<dim3(D / 128, M / 128), 256, 0, stream>>>((const bf16*)(ws + WS_PB), PLE, (const bf16*)(ws + WS_WPL), PLE, PLE, E7a{S(1)});
        k_gemm<E7b><<<dim3(D / 128, M / 128), 256, 0, stream>>>(S(0), D, (const bf16*)(ws + WS_WPG), D, D, E7b{S(1), H});
    }
    k_final<<<M, 256, 0, stream>>>(H, (const float*)d_in[24]);
#endif
}
```

```cpp
#define MEGA_HI 9
#define ONE_LAUNCH 1
#include <hip/hip_runtime.h>
#include <cstdio>
#include <cstdint>

#define LAS __attribute__((address_space(3)))
#define GAS __attribute__((address_space(1)))
typedef unsigned short bf16;
typedef short bf16x8 __attribute__((ext_vector_type(8)));
typedef float f32x2 __attribute__((ext_vector_type(2)));
typedef float f32x4 __attribute__((ext_vector_type(4)));
typedef float f32x16 __attribute__((ext_vector_type(16)));
typedef unsigned u32x2 __attribute__((ext_vector_type(2)));
typedef unsigned u32x4 __attribute__((ext_vector_type(4)));

constexpr int D = 1024, NB = 8, SEQ = 4096, DB = 8, DSEQ = 32, MP = NB * SEQ, MS = DB * DSEQ, M = MP + MS;
constexpr int FF = 4096, PLE = 256, INC = 6144, CW = 31, HIST = 30;
constexpr float EPS = 1e-6f;
constexpr int NWAVES = 8, NTHR = 512;

constexpr size_t MiB = 1u << 20;
constexpr size_t WS_CTL = 0, CTL_ZERO_BYTES = 64 * 1024;
constexpr size_t WS_WR = 1 * MiB;
constexpr size_t WS_WV = 11 * MiB;
constexpr size_t WS_WA = 13 * MiB, WS_WB = 15 * MiB, WS_WO = 17 * MiB;
constexpr size_t WS_WUP = 19 * MiB;
constexpr size_t WS_WDN = 27 * MiB;
constexpr size_t WS_WPG = 35 * MiB;
constexpr size_t WS_WPL = 37 * MiB;
constexpr size_t WS_WSG = 37 * MiB + 512 * 1024;
constexpr size_t WS_PB = 38 * MiB;
constexpr size_t SLOT = (size_t)M * D * 2;
constexpr size_t WS_S0 = 55 * MiB;
constexpr size_t WS_HSS1 = WS_S0 + 7 * SLOT;
constexpr size_t WS_HSS2 = WS_HSS1 + (size_t)M * 16 * 4;
constexpr size_t WS_PAR = WS_HSS2 + (size_t)M * 16 * 4;
constexpr size_t WS_END = WS_PAR + 1200 * 1024;
static_assert(WS_END <= 512 * MiB, "d_ws map");
constexpr int TP_WR = 0, TP_WV = 20, TP_XN = (int)((WS_S0 - WS_WR) / (512 * 1024));
static_assert((WS_S0 - WS_WR) % (512 * 1024) == 0 && (WS_WV - WS_WR) == 20 * 512 * 1024, "tile alignment");
constexpr int CW_BAR = 1024;

__device__ __forceinline__ unsigned f2bf(float f) { unsigned u = __builtin_bit_cast(unsigned, f); return (u + 0x7fffu + ((u >> 16) & 1u)) >> 16; }
__device__ __forceinline__ unsigned pk2(float lo, float hi) { return f2bf(lo) | (f2bf(hi) << 16); }
__device__ __forceinline__ float bflo(unsigned w) { return __builtin_bit_cast(float, w << 16); }
__device__ __forceinline__ float bfhi(unsigned w) { return __builtin_bit_cast(float, w & 0xffff0000u); }
__device__ __forceinline__ float bf2f(bf16 b) { return __builtin_bit_cast(float, (unsigned)b << 16); }
__device__ __forceinline__ float sigm(float x) { return 1.f / (1.f + __expf(-x)); }
#define LDS_WAIT() asm volatile("s_waitcnt lgkmcnt(0)" ::: "memory")
#define VM_WAIT() asm volatile("s_waitcnt vmcnt(0)" ::: "memory")

namespace pg8 {
constexpr int BM = 256, BK = 64, HALF = 128, HTB = HALF * BK * 2, STAGE_BYTES = 8 * HTB, NXCD = 8, WGM = 8;
__host__ __device__ __forceinline__ int lds_byte(int r, int c) { const int st = (r >> 4) * 2 + (c >> 5), rr = r & 15, cc = c & 31, ob = rr * 64 + cc * 2; return st * 1024 + (ob ^ (((ob >> 9) & 1) << 5)); }
__host__ __device__ __forceinline__ void stage_rc(int b, int& R, int& C) { const int st = b / 1024, sb = b % 1024, swz = sb ^ (((sb >> 9) & 1) << 5); R = (st >> 1) * 16 + swz / 64; C = (st & 1) * 32 + (swz % 64) / 2; }
__host__ __device__ __forceinline__ int perm32(int rho) { const int n = rho >> 4, i = rho & 15; return 8 * (i >> 2) + 4 * n + (i & 3); }

struct Unit { int pm, pn; };
struct Gemm { const char* A0; const char* A1; const char* B0; const char* B1; int lda0, lda1, ldb0, ldb1, nt, ts; };

struct StaticOrder {
    int nM, nN, nwg, G, c;
    __device__ void init(int nM_, int nN_, int G_, int c_) { nM = nM_; nN = nN_; nwg = nM * nN; G = G_; c = c_; }
    __device__ bool next(int i, Unit& u) const {
        const long L = (long)i * G + c; if (L >= nwg) return false;
        int wgid = (int)L; { const int q = nwg / NXCD, r = nwg % NXCD, xcd = wgid % NXCD, off = wgid / NXCD; wgid = (xcd < r ? xcd * (q + 1) : r * (q + 1) + (xcd - r) * q) + off; }
        const int nig = WGM * nN, gid = wgid / nig, fm = gid * WGM, gsz = (nM - fm) < WGM ? (nM - fm) : WGM;
        u.pm = fm + ((wgid % nig) % gsz); u.pn = (wgid % nig) / gsz; return true;
    }
};

template <class Epi, class Sched, bool DIFFLD = false>
__device__ __forceinline__ void gemm_phase(LAS unsigned char* lds, const Gemm g, const Sched& S, const Epi& E, const int tid) {
    const int wid = __builtin_amdgcn_readfirstlane(tid >> 6), lane = tid & 63, wr = wid >> 2, wc = wid & 3, fr = lane & 15, fq = lane >> 4;
    const int nt = g.nt, ts = g.ts;
    int R, C; stage_rc(tid * 16, R, C); const int Rb = Epi::PERM ? ((R & ~31) + perm32(R & 31)) : R;
    const unsigned vA0 = (unsigned)(R * g.lda0 + C) * 2u, vB0 = (unsigned)(Rb * g.ldb0 + C) * 2u;
    const unsigned rc = (unsigned)R | ((unsigned)Rb << 8) | ((unsigned)(2 * C) << 16);
    const size_t hA0 = (size_t)HALF * g.lda0 * 2, hA1 = (size_t)HALF * g.lda1 * 2, hB0 = (size_t)HALF * g.ldb0 * 2, hB1 = (size_t)HALF * g.ldb1 * 2;
    const unsigned ldsw = (unsigned)wid * 1024u;
    const int aoff = lds_byte(wr * 64 + fr, fq * 8), boff = lds_byte(wc * 32 + fr, fq * 8);
#define PG8_SA(b, h) (((b) * 2 + (h)) * HTB)
#define PG8_SB(b, h) ((4 + (b) * 2 + (h)) * HTB)
#define PG8_STAGE(bufoff, gbase, voff, hstep) do { \
        __builtin_amdgcn_global_load_lds((const unsigned*)((const char*)(gbase) + (voff)), (LAS unsigned*)(lds + (bufoff) + ldsw), 16, 0, 0); \
        __builtin_amdgcn_global_load_lds((const unsigned*)((const char*)(gbase) + ((hstep) >> 1) + (voff)), (LAS unsigned*)(lds + (bufoff) + ldsw + 8192), 16, 0, 0); } while (0)
#define PG8_LDA(dst, b, h) do { _Pragma("unroll") for (int m = 0; m < 4; ++m) _Pragma("unroll") for (int k = 0; k < 2; ++k) dst[m][k] = *(const LAS bf16x8*)(lds + PG8_SA(b, h) + aoff + m * 2048 + k * 1024); } while (0)
#define PG8_LDB(dst, b, h) do { _Pragma("unroll") for (int n = 0; n < 2; ++n) _Pragma("unroll") for (int k = 0; k < 2; ++k) dst[n][k] = *(const LAS bf16x8*)(lds + PG8_SB(b, h) + boff + n * 2048 + k * 1024); } while (0)
#define PG8_MMA(ai, bj, At, Bt) do { __builtin_amdgcn_s_setprio(1); _Pragma("unroll") for (int m = 0; m < 4; ++m) _Pragma("unroll") for (int n = 0; n < 2; ++n) _Pragma("unroll") for (int k = 0; k < 2; ++k) \
        acc[ai][bj][m][n] = __builtin_amdgcn_mfma_f32_16x16x32_bf16(Bt[n][k], At[m][k], acc[ai][bj][m][n], 0, 0, 0); __builtin_amdgcn_s_setprio(0); } while (0)
#define PG8_WAIT_V(n) asm volatile("s_waitcnt vmcnt(" #n ")" ::: "memory")
#define PG8_WAIT_L(n) asm volatile("s_waitcnt lgkmcnt(" #n ")" ::: "memory")
#define PG8_BAR __builtin_amdgcn_s_barrier()
#define PG8_SCHED __builtin_amdgcn_sched_barrier(0)
    Unit cur, nxt; int ui = 0;
    if (!S.next(0, cur)) return;
    f32x4 acc[2][2][4][2];
#pragma unroll
    for (int a = 0; a < 2; ++a)
#pragma unroll
        for (int b = 0; b < 2; ++b)
#pragma unroll
            for (int m = 0; m < 4; ++m)
#pragma unroll
                for (int n = 0; n < 2; ++n) acc[a][b][m][n] = (f32x4){0.f, 0.f, 0.f, 0.f};
    bf16x8 At[4][2], B0[2][2], B1[2][2];
    {
        const char* cA = g.A0 + (size_t)cur.pm * (2 * hA0); const char* cB = g.B0 + (size_t)cur.pn * (2 * hB0);
        PG8_STAGE(PG8_SB(0, 0), cB, vB0, hB0); PG8_STAGE(PG8_SB(0, 1), cB + hB0, vB0, hB0); PG8_STAGE(PG8_SA(0, 0), cA, vA0, hA0); PG8_STAGE(PG8_SA(0, 1), cA + hA0, vA0, hA0);
        if (wr == 1) PG8_BAR;
        PG8_WAIT_V(2); PG8_BAR;
        PG8_STAGE(PG8_SB(1, 0), cB + 128, vB0, hB0); PG8_STAGE(PG8_SA(1, 0), cA + 128, vA0, hA0); PG8_STAGE(PG8_SB(1, 1), cB + hB0 + 128, vB0, hB0);
        PG8_WAIT_V(6); PG8_BAR;
    }
    for (;;) {
        const bool has_next = S.next(ui + 1, nxt);
        for (int t = 0; t < nt; t += 2) {
            if constexpr (Epi::HAS_MID) { if (t == ts) E.mid(acc, cur, wr, wc, fr, fq); }
            const bool last = (t == nt - 2);
            const bool sc = t >= ts;
            const char* a1 = sc ? g.A1 + (size_t)cur.pm * (2 * hA1) + (size_t)(t + 1 - ts) * 128 : g.A0 + (size_t)cur.pm * (2 * hA0) + (size_t)(t + 1) * 128;
            unsigned vAc = vA0; if constexpr (DIFFLD) { if (sc) vAc = (rc & 0xffu) * (unsigned)(2 * g.lda1) + (rc >> 16); }
            const size_t hAc = sc ? hA1 : hA0;
            const int upm = (last && has_next) ? nxt.pm : cur.pm, upn = (last && has_next) ? nxt.pn : cur.pn, tt = last ? 0 : t + 2;
            const bool sn = tt >= ts;
            const char* a2 = sn ? g.A1 + (size_t)upm * (2 * hA1) + (size_t)(tt - ts) * 128 : g.A0 + (size_t)upm * (2 * hA0) + (size_t)tt * 128;
            const char* b2 = sn ? g.B1 + (size_t)upn * (2 * hB1) + (size_t)(tt - ts) * 128 : g.B0 + (size_t)upn * (2 * hB0) + (size_t)tt * 128;
            unsigned vAn = vA0, vBn = vB0; if constexpr (DIFFLD) { if (sn) { vAn = (rc & 0xffu) * (unsigned)(2 * g.lda1) + (rc >> 16); vBn = ((rc >> 8) & 0xffu) * (unsigned)(2 * g.ldb1) + (rc >> 16); } }
            const size_t hAn = sn ? hA1 : hA0, hBn = sn ? hB1 : hB0;
            const char* a3 = a2 + 128; const char* b3 = b2 + 128;
            PG8_LDB(B0, 0, 0); PG8_LDB(B1, 0, 1); PG8_SCHED; PG8_LDA(At, 0, 0); PG8_STAGE(PG8_SA(1, 1), a1 + hAc, vAc, hAc);
            PG8_WAIT_V(8); PG8_WAIT_L(0); PG8_BAR; PG8_MMA(0, 0, At, B0); PG8_MMA(0, 1, At, B1); PG8_BAR; PG8_SCHED;
            PG8_LDA(At, 0, 1); PG8_STAGE(PG8_SB(0, 0), b2, vBn, hBn); PG8_STAGE(PG8_SB(0, 1), b2 + hBn, vBn, hBn); PG8_STAGE(PG8_SA(0, 0), a2, vAn, hAn);
            PG8_WAIT_V(8); PG8_WAIT_L(0); PG8_BAR; PG8_MMA(1, 0, At, B0); PG8_MMA(1, 1, At, B1); PG8_BAR; PG8_SCHED;
            PG8_LDB(B0, 1, 0); PG8_LDB(B1, 1, 1); PG8_SCHED; PG8_LDA(At, 1, 0); PG8_STAGE(PG8_SA(0, 1), a2 + hAn, vAn, hAn);
            PG8_WAIT_V(8); PG8_WAIT_L(0); PG8_BAR; PG8_MMA(0, 0, At, B0); PG8_MMA(0, 1, At, B1); PG8_BAR; PG8_SCHED;
            PG8_LDA(At, 1, 1); PG8_STAGE(PG8_SB(1, 0), b3, vBn, hBn); PG8_STAGE(PG8_SB(1, 1), b3 + hBn, vBn, hBn); PG8_STAGE(PG8_SA(1, 0), a3, vAn, hAn);
            PG8_WAIT_V(8); PG8_WAIT_L(0); PG8_BAR; PG8_MMA(1, 0, At, B0); PG8_MMA(1, 1, At, B1); PG8_BAR; PG8_SCHED;
        }
        if (wr == 0) PG8_BAR;
        E(acc, cur, wr, wc, fr, fq);
        if (!has_next) break;
#pragma unroll
        for (int a = 0; a < 2; ++a)
#pragma unroll
            for (int b = 0; b < 2; ++b)
#pragma unroll
                for (int m = 0; m < 4; ++m)
#pragma unroll
                    for (int n = 0; n < 2; ++n) acc[a][b][m][n] = (f32x4){0.f, 0.f, 0.f, 0.f};
        cur = nxt; ++ui;
        if (wr == 1) PG8_BAR;
    }
    PG8_WAIT_V(0);
    PG8_BAR;
#undef PG8_SA
#undef PG8_SB
#undef PG8_STAGE
#undef PG8_LDA
#undef PG8_LDB
#undef PG8_MMA
#undef PG8_WAIT_V
#undef PG8_WAIT_L
#undef PG8_BAR
#undef PG8_SCHED
}
}
constexpr int RING_OFF = 0, RING_BYTES = 131072;
constexpr int LDSCTL_OFF = RING_BYTES, MISC_OFF = LDSCTL_OFF + 320;
constexpr int LDS_BYTES = 147456;
static_assert(MISC_OFF + 128 <= LDS_BYTES, "LDS map");

#define XB_TMO      128
#define XB_XCNT(j)  (256  + 64 * (j))
#define XB_XSUB(j)  (1280 + 64 * (j))
#define XB_XGEN(j)  (2304 + 64 * (j))
#define XB_TOP      3328
#define XB_TOPGEN   3392
#define XCD_BAR_WORDS 3456
#define XB_SPIN_CAP (1u << 18)
__device__ __forceinline__ unsigned xb_ld(unsigned* p)              { return __hip_atomic_load(p, __ATOMIC_RELAXED, __HIP_MEMORY_SCOPE_AGENT); }
__device__ __forceinline__ unsigned xb_add(unsigned* p, unsigned v) { return __hip_atomic_fetch_add(p, v, __ATOMIC_RELAXED, __HIP_MEMORY_SCOPE_AGENT); }
__device__ __forceinline__ unsigned xb_xcc_id() { return (unsigned)__builtin_amdgcn_s_getreg((3 << 11) | 20) & 0xFu; }
#define XB_SPIN(cond, bar) do { unsigned _sp = 0; while (cond) { __builtin_amdgcn_s_sleep(1); \
    if ((++_sp & 255u) == 0u) { if (xb_ld(&(bar)[XB_TMO])) break; if (_sp > XB_SPIN_CAP) { atomicAdd(&(bar)[XB_TMO], 1u); break; } } } } while (0)
struct XcdBarrier { unsigned* bar; unsigned x; volatile LAS unsigned* st; };
__device__ __forceinline__ XcdBarrier xcd_barrier_post(unsigned* bar, volatile LAS unsigned* st, const bool leader) {
    XcdBarrier b; b.bar = bar; b.x = xb_xcc_id(); b.st = st;
    if (leader) (void)xb_add(&bar[XB_XCNT(b.x)], 1u);
    return b;
}
__device__ __forceinline__ void xcd_barrier_complete(unsigned* bar, unsigned x, unsigned& nloc, unsigned& nx) {
    const unsigned G = gridDim.x * gridDim.y * gridDim.z;
    unsigned sum, cnt, mine, sp = 0u;
    for (;;) {
        sum = 0u; cnt = 0u; mine = 0u;
#pragma unroll
        for (unsigned j = 0; j < 16; ++j) { const unsigned c = xb_ld(&bar[XB_XCNT(j)]); sum += c; cnt += (c > 0u) ? 1u : 0u; mine = (j == x) ? c : mine; }
        if (sum == G) break;
        __builtin_amdgcn_s_sleep(1);
        if ((++sp & 255u) == 0u) { if (xb_ld(&bar[XB_TMO])) break; if (sp > XB_SPIN_CAP) { atomicAdd(&bar[XB_TMO], 1u); break; } }
    }
    nloc = mine > 0u ? mine : 1u; nx = cnt > 0u ? cnt : 1u;
}
__device__ __forceinline__ void xcd_barrier(const XcdBarrier& b, const bool leader  ) {
    asm volatile("s_waitcnt vmcnt(0)" ::: "memory");
    __syncthreads();
    if (leader) {
        unsigned* bar = b.bar;
        __builtin_amdgcn_s_waitcnt(0);
        unsigned nloc = b.st[0], nx = b.st[1];
        if (nloc == 0u) { xcd_barrier_complete(bar, b.x, nloc, nx); b.st[0] = nloc; b.st[1] = nx; }
        const unsigned old = xb_add(&bar[XB_XSUB(b.x)], 1u);
        const unsigned gen = old / nloc;
        if (old + 1u == (gen + 1u) * nloc) {
            __builtin_amdgcn_fence(__ATOMIC_RELEASE, "agent");
            asm volatile("s_waitcnt vmcnt(0)" ::: "memory");
            const unsigned og = xb_add(&bar[XB_TOP], 1u);
            const unsigned tg = og / nx;
            if (og + 1u == (tg + 1u) * nx) xb_add(&bar[XB_TOPGEN], 1u);
            else XB_SPIN(xb_ld(&bar[XB_TOPGEN]) == tg, bar);
            __builtin_amdgcn_fence(__ATOMIC_ACQUIRE, "agent");
            xb_add(&bar[XB_XGEN(b.x)], 1u);
            asm volatile("s_waitcnt vmcnt(0)" ::: "memory");
        } else {
            XB_SPIN(xb_ld(&bar[XB_XGEN(b.x)]) == gen, bar);
            __builtin_amdgcn_fence(__ATOMIC_ACQUIRE, "agent");
            asm volatile("s_waitcnt vmcnt(0)" ::: "memory");
        }
    }
    __syncthreads();
}

struct Frame {
    LAS unsigned char* lds;
    int tid, lane, wave, G, vcu;
    float* out; unsigned char* ws;
};
struct Args { const float* in[25]; float* out; unsigned char* ws; int ph_lo, ph_hi; };
constexpr int PO_GSGV = 0, PO_BSGV = 1024, PO_BSG = 2048, PO_BDW = 3072, PO_GCLN = 4096, PO_BCLN = 5120, PO_GFIN = 6144, PO_WDW = 7168, PO_CACHE = PO_WDW + CW * D, PO_END = PO_CACHE + DB * HIST * D;
__device__ __forceinline__ const float* par(const Frame& F, int off) { return (const float*)(F.ws + WS_PAR) + off; }
__device__ __forceinline__ int lane_id() { int l; asm volatile("v_mbcnt_lo_u32_b32 %0, -1, 0\n\tv_mbcnt_hi_u32_b32 %0, -1, %0" : "=v"(l)); return l; }
#define PHASE_IDS(F) do { (F).lane = lane_id(); (F).tid = (F).wave * 64 + (F).lane; } while (0)
__device__ __forceinline__ bf16* wsb(const Frame& F, size_t off) { return (bf16*)(F.ws + off); }
__device__ __forceinline__ bf16* slot(const Frame& F, int i) { return (bf16*)(F.ws + WS_S0 + (size_t)i * SLOT); }
__device__ __forceinline__ float wave_sum(float v) {
#pragma unroll
    for (int o = 1; o < 64; o <<= 1) v += __shfl_xor(v, o);
    return v;
}

__device__ __forceinline__ void tr_item(const float* W, int Nsrc, int K, int k0, int s0, const float* gk, bf16* WT, int d0, LAS float* scr, int lane) {
#pragma unroll 8
    for (int i = 0; i < 32; ++i) { const int kk = 2 * i + (lane >> 5); float v = W[(size_t)(k0 + kk) * Nsrc + s0 + (lane & 31)]; if (gk) v *= gk[k0 + kk]; scr[kk * 33 + (lane & 31)] = v; }
    LDS_WAIT(); asm volatile("" ::: "memory");
    const int c = lane & 7;
#pragma unroll
    for (int j = 0; j < 4; ++j) { const int n = (lane >> 3) + 8 * j; const LAS float* s = scr + (8 * c) * 33 + n;
        u32x4 o; o.x = pk2(s[0 * 33], s[1 * 33]); o.y = pk2(s[2 * 33], s[3 * 33]); o.z = pk2(s[4 * 33], s[5 * 33]); o.w = pk2(s[6 * 33], s[7 * 33]);
        *(u32x4*)(WT + (size_t)(d0 + n) * K + k0 + 8 * c) = o; }
    LDS_WAIT(); asm volatile("" ::: "memory");
}
__device__ __forceinline__ int wr_src_col(int d) {
    if (d < 1024) return d;
    const int base = d < 3072 ? 2048 : 4096, e = d < 3072 ? d - 1024 : d - 3072;
    return base + 1024 * ((e >> 7) & 1) + 128 * (e >> 8) + (e & 127);
}
__device__ __forceinline__ void p0_prologue(Frame& F, const Args& A) {
    LAS float* scr = (LAS float*)(F.lds + RING_OFF + F.wave * 16384);
    const int gw = F.vcu * NWAVES + F.wave, NGW = F.G * NWAVES, lane = F.lane;
    constexpr int I_WR = 16 * 160, I_WV = 16 * 32, I_SQ = 16 * 32, I_UP = 16 * 128, I_DN = 64 * 32, I_PL = 4 * 32;
    constexpr int NITEMS = I_WR + I_WV + 4 * I_SQ + I_UP + I_DN + I_PL;
    for (int it = gw; it < NITEMS; it += NGW) {
        int r = it;
        if (r < I_WR) { const int kb = r / 160, nb = r % 160; tr_item(A.in[6], INC, D, 64 * kb, wr_src_col(32 * nb), nullptr, wsb(F, WS_WR), 32 * nb, scr, lane); continue; } r -= I_WR;
        if (r < I_WV) { const int kb = r / 32, nb = r % 32; tr_item(A.in[6], INC, D, 64 * kb, 1024 + 32 * nb, nullptr, wsb(F, WS_WV), 32 * nb, scr, lane); continue; } r -= I_WV;
        if (r < I_SQ) { const int kb = r / 32, nb = r % 32; tr_item(A.in[11], D, D, 64 * kb, 32 * nb, nullptr, wsb(F, WS_WA), 32 * nb, scr, lane); continue; } r -= I_SQ;
        if (r < I_SQ) { const int kb = r / 32, nb = r % 32; tr_item(A.in[16], D, D, 64 * kb, 32 * nb, nullptr, wsb(F, WS_WB), 32 * nb, scr, lane); continue; } r -= I_SQ;
        if (r < I_SQ) { const int kb = r / 32, nb = r % 32; tr_item(A.in[17], D, D, 64 * kb, 32 * nb, nullptr, wsb(F, WS_WO), 32 * nb, scr, lane); continue; } r -= I_SQ;
        if (r < I_SQ) { const int kb = r / 32, nb = r % 32; tr_item(A.in[22], D, D, 64 * kb, 32 * nb, A.in[21], wsb(F, WS_WPG), 32 * nb, scr, lane); continue; } r -= I_SQ;
        if (r < I_UP) { const int kb = r / 128, nb = r % 128; tr_item(A.in[19], FF, D, 64 * kb, 32 * nb, A.in[18], wsb(F, WS_WUP), 32 * nb, scr, lane); continue; } r -= I_UP;
        if (r < I_DN) { const int kb = r / 32, nb = r % 32; tr_item(A.in[20], D, FF, 64 * kb, 32 * nb, nullptr, wsb(F, WS_WDN), 32 * nb, scr, lane); continue; } r -= I_DN;
        { const int kb = r / 32, nb = r % 32; tr_item(A.in[23], D, PLE, 64 * kb, 32 * nb, nullptr, wsb(F, WS_WPL), 32 * nb, scr, lane); }
    }
    for (int rr = gw; rr < 8 * 128 / 2; rr += NGW) { const int row = 2 * rr + (lane >> 5), t = row & 127, s0 = 4 * (lane & 31);
        const f32x4 w = *(const f32x4*)(A.in[9] + (size_t)row * 128 + s0); u32x2 o;
        o.x = pk2(s0 + 0 <= t ? w.x : 0.f, s0 + 1 <= t ? w.y : 0.f); o.y = pk2(s0 + 2 <= t ? w.z : 0.f, s0 + 3 <= t ? w.w : 0.f);
        *(u32x2*)(wsb(F, WS_WSG) + (size_t)row * 128 + s0) = o; }
    { float* P = (float*)(F.ws + WS_PAR); const int gt = gw * 64 + lane, NT_ = NGW * 64;
      for (int i = gt; i < PO_END / 4; i += NT_) { const int o = 4 * i; const float* src;
          if (o < PO_BSGV) src = A.in[7] + o; else if (o < PO_BSG) src = A.in[8] + (o - PO_BSGV); else if (o < PO_BDW) src = A.in[10] + (o - PO_BSG); else if (o < PO_GCLN) src = A.in[13] + (o - PO_BDW);
          else if (o < PO_BCLN) src = A.in[14] + (o - PO_GCLN); else if (o < PO_GFIN) src = A.in[15] + (o - PO_BCLN); else if (o < PO_WDW) src = A.in[24] + (o - PO_GFIN);
          else if (o < PO_CACHE) src = A.in[12] + (o - PO_WDW); else src = A.in[2] + (o - PO_CACHE);
          *(f32x4*)(P + o) = *(const f32x4*)src; } }
    bf16* XN = slot(F, 0); bf16* PB = wsb(F, WS_PB);
    f32x4 gm[4];
#pragma unroll
    for (int j = 0; j < 4; ++j) gm[j] = *(const f32x4*)(A.in[5] + 4 * lane + 256 * j);
    for (int m = gw; m < M; m += NGW) {
        const float* xr = m < MP ? A.in[0] + (size_t)m * D : A.in[1] + (size_t)(m - MP) * D;
        const float* pr = m < MP ? A.in[3] + (size_t)m * PLE : A.in[4] + (size_t)(m - MP) * PLE;
        f32x4 v[4]; float s = 0.f;
#pragma unroll
        for (int j = 0; j < 4; ++j) { v[j] = *(const f32x4*)(xr + 4 * lane + 256 * j); s += (v[j].x * v[j].x + v[j].y * v[j].y) + (v[j].z * v[j].z + v[j].w * v[j].w); }
        const f32x4 pv = *(const f32x4*)(pr + 4 * lane);
        const float rs = 1.f / sqrtf(wave_sum(s) * (1.f / D) + EPS);
#pragma unroll
        for (int j = 0; j < 4; ++j) { u32x2 o; o.x = pk2(v[j].x * rs * gm[j].x, v[j].y * rs * gm[j].y); o.y = pk2(v[j].z * rs * gm[j].z, v[j].w * rs * gm[j].w);
            *(u32x2*)(XN + (size_t)m * D + 4 * lane + 256 * j) = o; }
        u32x2 po; po.x = pk2(pv.x, pv.y); po.y = pk2(pv.z, pv.w); *(u32x2*)(PB + (size_t)m * PLE + 4 * lane) = po;
    }
}

struct SchedP1 {
    pg8::StaticOrder so;
    __device__ void init(int G, int c) { so.init(MP / 256, 24, G, c); }
    __device__ bool next(int i, pg8::Unit& u) const {
        pg8::Unit v; if (!so.next(i, v)) return false;
        if (v.pn < 20) { u.pm = TP_XN + v.pm; u.pn = TP_WR + v.pn; } else { u.pm = TP_WV + (v.pn - 20); u.pn = TP_XN + v.pm; }
        return true;
    }
};
__device__ __forceinline__ u32x4 pack8(const f32x4 a, const f32x4 b) { u32x4 w; w.x = pk2(a.x, a.y); w.y = pk2(a.z, a.w); w.z = pk2(b.x, b.y); w.w = pk2(b.z, b.w); return w; }
struct EpiP1 {
    static constexpr bool PERM = true, HAS_MID = false;
    bf16 *U, *VT, *C, *RR, *SGB; float *csp, *css;
    __device__ __forceinline__ void mid(f32x4 (&acc)[2][2][4][2], const pg8::Unit& u, int wr, int wc, int, int) const {}
    __device__ __forceinline__ void operator()(const f32x4 (&acc)[2][2][4][2], const pg8::Unit& u, int wr, int wc, int, int) const {
        const int lane_ = lane_id(), fr = lane_ & 15, fq = lane_ >> 4;
        if (u.pm >= TP_WV && u.pm < TP_WV + 4) {
            const int ch0 = (u.pm - TP_WV) * 256 + wr * 64 + fr, tok0 = (u.pn - TP_XN) * 256 + wc * 32 + 8 * fq;
#pragma unroll
            for (int ai = 0; ai < 2; ++ai)
#pragma unroll
                for (int m = 0; m < 4; ++m) { bf16* rowp = VT + (size_t)(ch0 + ai * 128 + m * 16) * M + tok0;
#pragma unroll
                    for (int bj = 0; bj < 2; ++bj) *(u32x4*)(rowp + bj * 128) = pack8(acc[ai][bj][m][0], acc[ai][bj][m][1]); }
            return;
        }
        const int row0 = (u.pm - TP_XN) * 256 + wr * 64 + fr, j = u.pn - TP_WR;
        if (j < 4) {
            const int col0 = j * 256 + wc * 32 + 8 * fq;
#pragma unroll
            for (int ai = 0; ai < 2; ++ai)
#pragma unroll
                for (int m = 0; m < 4; ++m) { bf16* rowp = U + (size_t)(row0 + ai * 128 + m * 16) * D + col0;
#pragma unroll
                    for (int bj = 0; bj < 2; ++bj) *(u32x4*)(rowp + bj * 128) = pack8(acc[ai][bj][m][0], acc[ai][bj][m][1]); }
        } else if (j < 12) {
            const int ch0 = (j - 4) * 128 + wc * 32 + 8 * fq;
#pragma unroll
            for (int ai = 0; ai < 2; ++ai)
#pragma unroll
                for (int m = 0; m < 4; ++m) { const int row = row0 + ai * 128 + m * 16; f32x4 c0, c1;
#pragma unroll
                    for (int e = 0; e < 4; ++e) { c0[e] = acc[ai][0][m][0][e] * sigm(acc[ai][1][m][0][e]); c1[e] = acc[ai][0][m][1][e] * sigm(acc[ai][1][m][1][e]); }
                    *(u32x4*)(C + (size_t)row * D + ch0) = pack8(c0, c1);
                    float* cs = nullptr;
                    if (row < MP) { const int t = row & (SEQ - 1); if (t >= SEQ - HIST) cs = csp + ((size_t)(row >> 12) * HIST + (t - (SEQ - HIST))) * D; }
                    else { const int rr = row - MP, t = rr & (DSEQ - 1); if (t >= DSEQ - HIST) cs = css + ((size_t)(rr >> 5) * HIST + (t - (DSEQ - HIST))) * D; }
                    if (cs) { *(f32x4*)(cs + ch0) = c0; *(f32x4*)(cs + ch0 + 4) = c1; } }
        } else {
            const int ch0 = (j - 12) * 128 + wc * 32 + 8 * fq;
#pragma unroll
            for (int ai = 0; ai < 2; ++ai)
#pragma unroll
                for (int m = 0; m < 4; ++m) { const int row = row0 + ai * 128 + m * 16; f32x4 r0, r1, s0, s1;
#pragma unroll
                    for (int e = 0; e < 4; ++e) {
                        const float ea0 = __expf(-acc[ai][0][m][0][e]), eb0 = __expf(-acc[ai][1][m][0][e]), ea1 = __expf(-acc[ai][0][m][1][e]), eb1 = __expf(-acc[ai][1][m][1][e]);
                        s0[e] = 1.f / (1.f + eb0); s1[e] = 1.f / (1.f + eb1); r0[e] = (1.f + eb0) / (1.f + ea0); r1[e] = (1.f + eb1) / (1.f + ea1); }
                    *(u32x4*)(RR + (size_t)row * D + ch0) = pack8(r0, r1); *(u32x4*)(SGB + (size_t)row * D + ch0) = pack8(s0, s1); }
        }
    }
};

__device__ __forceinline__ float lane_sel(unsigned long long m, float a, float b) { float r; asm("v_cndmask_b32_e64 %0, %1, %2, %3" : "=v"(r) : "v"(a), "v"(b), "s"(m)); return r; }
#define LDS_BARRIER() do { asm volatile("s_waitcnt lgkmcnt(0)" ::: "memory"); __builtin_amdgcn_s_barrier(); asm volatile("" ::: "memory"); } while (0)
template <int NT>
__device__ __forceinline__ void sg_stats(Frame& F, const bf16* VT, int row0, LAS float* red, LAS float* ST) {
    constexpr int NO = NT / 8, CS = 64 / NO, NI = 1024 / (CS * 8);
    const int lane = F.lane, wave = F.wave, tid = F.tid, o = lane % NO, cs = lane / NO;
    float s[8], q[8];
#pragma unroll
    for (int j = 0; j < 8; ++j) { s[j] = 0.f; q[j] = 0.f; }
#pragma unroll 16
    for (int i = 0; i < NI; ++i) { const int ch = (i * 8 + wave) * CS + cs; const u32x4 v = *(const u32x4*)(VT + (size_t)ch * M + row0 + 8 * o);
#pragma unroll
        for (int j = 0; j < 4; ++j) { const float lo = bflo(v[j]), hi = bfhi(v[j]); s[2 * j] += lo; q[2 * j] += lo * lo; s[2 * j + 1] += hi; q[2 * j + 1] += hi * hi; } }
#pragma unroll
    for (int off = NO; off < 64; off <<= 1)
#pragma unroll
        for (int j = 0; j < 8; ++j) { s[j] += __shfl_xor(s[j], off); q[j] += __shfl_xor(q[j], off); }
    if (lane < NO)
#pragma unroll
        for (int j = 0; j < 8; ++j) { red[(wave * NT + 8 * o + j) * 2] = s[j]; red[(wave * NT + 8 * o + j) * 2 + 1] = q[j]; }
    LDS_BARRIER();
    if (tid < NT) { float S = 0.f, Q = 0.f;
#pragma unroll
        for (int w = 0; w < 8; ++w) { S += red[(w * NT + tid) * 2]; Q += red[(w * NT + tid) * 2 + 1]; }
        const float mu = S * (1.f / D), var = Q * (1.f / D) - mu * mu; ST[2 * tid] = mu; ST[2 * tid + 1] = 1.f / sqrtf(var + EPS); }
    LDS_BARRIER();
}
__device__ __forceinline__ void sg_epi(const f32x16& acc, const u32x2 (&uu)[4], float bias, bf16* Arow, int h) {
#pragma unroll
    for (int eg = 0; eg < 4; ++eg) { u32x2 o; o.x = pk2(bflo(uu[eg].x) * (acc[4 * eg] + bias), bfhi(uu[eg].x) * (acc[4 * eg + 1] + bias)); o.y = pk2(bflo(uu[eg].y) * (acc[4 * eg + 2] + bias), bfhi(uu[eg].y) * (acc[4 * eg + 3] + bias));
        *(u32x2*)(Arow + 8 * eg + 4 * h) = o; }
}
template <int PAIR>
__device__ __forceinline__ void sg_group_mma(Frame& F, const LAS unsigned char* tile, const bf16* WSG, const bf16* U, bf16* A, int row0, int g) {
    constexpr int tbA = PAIR ? 1 : 0, tbB = PAIR ? 2 : 3, nks = 2 * (tbB + 1), nksA = 2 * (tbA + 1);
    const int lane = F.lane, r = lane & 31, h = lane >> 5, cb = F.wave & 3;
    const bf16* wA = WSG + ((size_t)g * 128 + 32 * tbA + r) * 128 + 8 * h; const bf16* wB = WSG + ((size_t)g * 128 + 32 * tbB + r) * 128 + 8 * h;
    bf16x8 bB[nks], bA[nksA];
#pragma unroll
    for (int ks = 0; ks < nks; ++ks) bB[ks] = *(const bf16x8*)(wB + 16 * ks);
#pragma unroll
    for (int ks = 0; ks < nksA; ++ks) bA[ks] = *(const bf16x8*)(wA + 16 * ks);
    const size_t offA = (size_t)(row0 + 32 * tbA + r) * D + g * 128 + cb * 32, offB = (size_t)(row0 + 32 * tbB + r) * D + g * 128 + cb * 32;
    u32x2 uA[4], uB[4];
#pragma unroll
    for (int eg = 0; eg < 4; ++eg) { uA[eg] = *(const u32x2*)(U + offA + 8 * eg + 4 * h); uB[eg] = *(const u32x2*)(U + offB + 8 * eg + 4 * h); }
    const float biasA = par(F, PO_BSG)[g * 128 + 32 * tbA + r], biasB = par(F, PO_BSG)[g * 128 + 32 * tbB + r];
    f32x16 accA, accB;
#pragma unroll
    for (int e = 0; e < 16; ++e) { accA[e] = 0.f; accB[e] = 0.f; }
    const int arow = cb * 32 + r;
#pragma unroll
    for (int ks = 0; ks < nks; ++ks) {
        const bf16x8 a = *(const LAS bf16x8*)(tile + arow * 256 + (((2 * ks + h) ^ (arow & 15)) << 4));
        accB = __builtin_amdgcn_mfma_f32_32x32x16_bf16(a, bB[ks], accB, 0, 0, 0);
        if (ks < nksA) accA = __builtin_amdgcn_mfma_f32_32x32x16_bf16(a, bA[ks], accA, 0, 0, 0);
    }
    sg_epi(accA, uA, biasA, A + offA, h); sg_epi(accB, uB, biasB, A + offB, h);
}
__device__ __forceinline__ void sg_item128(Frame& F, int row0) {
    LAS float* ST = (LAS float*)(F.lds);
    LAS float* red = (LAS float*)(F.lds + 1024);
    LAS unsigned char* tiles = F.lds + 16384;
    const bf16* VT = slot(F, 2); const bf16* U = slot(F, 1); bf16* A = slot(F, 0); const bf16* WSG = wsb(F, WS_WSG);
    PHASE_IDS(F);
    const int tid = F.tid;
    LDS_BARRIER();
    sg_stats<128>(F, VT, row0, red, ST);
    const int so = tid & 15, c0 = tid >> 4;
    float mu[8], rho[8];
#pragma unroll
    for (int p = 0; p < 4; ++p) { const f32x4 s4 = *(const LAS f32x4*)(ST + 2 * (8 * so) + 4 * p); mu[2 * p] = s4.x; rho[2 * p] = s4.y; mu[2 * p + 1] = s4.z; rho[2 * p + 1] = s4.w; }
    u32x4 raw[4];
    auto issue = [&](int g) {
        const bf16* vt = VT + (size_t)(g * 128) * M + row0; asm volatile("" : "+s"(vt));
#pragma unroll
        for (int i = 0; i < 4; ++i) raw[i] = *(const u32x4*)(vt + (size_t)(c0 + 32 * i) * M + 8 * so); };
    auto stage = [&](int g, LAS unsigned char* tile) {
#pragma unroll
        for (int i = 0; i < 4; ++i) { const int ch = c0 + 32 * i; const float gam = par(F, PO_GSGV)[g * 128 + ch], bet = par(F, PO_BSGV)[g * 128 + ch]; u32x4 w;
#pragma unroll
            for (int p = 0; p < 4; ++p) w[p] = pk2((bflo(raw[i][p]) - mu[2 * p]) * (rho[2 * p] * gam) + bet, (bfhi(raw[i][p]) - mu[2 * p + 1]) * (rho[2 * p + 1] * gam) + bet);
            *(LAS u32x4*)(tile + ch * 256 + ((so ^ (ch & 15)) << 4)) = w; } };
    issue(0); stage(0, tiles);
    LDS_BARRIER();
#pragma clang loop unroll(disable)
    for (int g = 0; g < 8; ++g) {
        LAS unsigned char* cur = tiles + (g & 1) * 32768;
        if (g < 7) issue(g + 1);
        if (F.wave >> 2) sg_group_mma<1>(F, cur, WSG, U, A, row0, g); else sg_group_mma<0>(F, cur, WSG, U, A, row0, g);
        if (g < 7) stage(g + 1, tiles + ((g + 1) & 1) * 32768);
        LDS_BARRIER();
    }
}
__device__ __forceinline__ void sg_item32(Frame& F, int row0, float* sgv_out) {
    LAS float* ST = (LAS float*)(F.lds); LAS float* red = (LAS float*)(F.lds + 1024);
    const bf16* VT = slot(F, 2); const bf16* U = slot(F, 1); bf16* A = slot(F, 0); const bf16* WSG = wsb(F, WS_WSG);
    PHASE_IDS(F);
    const int lane = F.lane, r = lane & 31, h = lane >> 5, g = F.wave;
    LDS_BARRIER();
    sg_stats<32>(F, VT, row0, red, ST);
    for (int cb = 0; cb < 4; ++cb) {
        const int ch = g * 128 + cb * 32 + r; const float gam = par(F, PO_GSGV)[ch], bet = par(F, PO_BSGV)[ch];
        const bf16* vrow = VT + (size_t)ch * M + row0 + 8 * h; const bf16* wA = WSG + ((size_t)g * 128 + r) * 128 + 8 * h;
        const size_t off = (size_t)(row0 + r) * D + g * 128 + cb * 32; u32x2 uu[4];
#pragma unroll
        for (int eg = 0; eg < 4; ++eg) uu[eg] = *(const u32x2*)(U + off + 8 * eg + 4 * h);
        f32x16 acc;
#pragma unroll
        for (int e = 0; e < 16; ++e) acc[e] = 0.f;
#pragma unroll
        for (int ks = 0; ks < 2; ++ks) {
            const u32x4 v = *(const u32x4*)(vrow + 16 * ks); const LAS f32x4* st = (const LAS f32x4*)(ST + 2 * (16 * ks + 8 * h)); float y[8];
#pragma unroll
            for (int p = 0; p < 4; ++p) { const f32x4 s4 = st[p]; y[2 * p] = (bflo(v[p]) - s4.x) * (s4.y * gam) + bet; y[2 * p + 1] = (bfhi(v[p]) - s4.z) * (s4.w * gam) + bet; }
#pragma unroll
            for (int j = 0; j < 8; ++j) sgv_out[(size_t)(16 * ks + 8 * h + j) * D + ch] = y[j];
            u32x4 w; w.x = pk2(y[0], y[1]); w.y = pk2(y[2], y[3]); w.z = pk2(y[4], y[5]); w.w = pk2(y[6], y[7]);
            const bf16x8 b = *(const bf16x8*)(wA + 16 * ks);
            acc = __builtin_amdgcn_mfma_f32_32x32x16_bf16(__builtin_bit_cast(bf16x8, w), b, acc, 0, 0, 0); }
        sg_epi(acc, uu, par(F, PO_BSG)[g * 128 + r], A + off, h);
    }
}
template <int NT>
__device__ __forceinline__ void conv_item(Frame& F, int row0, int hist_mode  , const float* cache_b) {
    LAS float* wred = (LAS float*)(F.lds + 90112);
    LAS float* ST2 = (LAS float*)(F.lds + 90112 + 1024);
    const bf16* C = slot(F, 3); bf16* BB = slot(F, 6);
    PHASE_IDS(F);
    const int tid = F.tid, lane = F.lane, wave = F.wave, c2 = 2 * tid;
    f32x2 w[CW];
    { const float* wp = par(F, PO_WDW) + c2;
#pragma unroll
      for (int j = 0; j < CW; ++j) { w[j] = *(const GAS f32x2*)wp; wp += D; asm volatile("" : "+v"(wp)); } }
    const f32x2 bd = *(const f32x2*)(par(F, PO_BDW) + c2), gc = *(const f32x2*)(par(F, PO_GCLN) + c2), bc = *(const f32x2*)(par(F, PO_BCLN) + c2);
    LDS_BARRIER();
    f32x2 win[HIST + 8];
#pragma unroll
    for (int i = 0; i < HIST + 8; ++i) win[i] = (f32x2){0.f, 0.f};
    if (hist_mode == 1) {
        const bf16* hp = C + (size_t)(row0 - HIST) * D + c2;
#pragma unroll
        for (int i = 0; i < HIST; ++i) { const unsigned v = *(const unsigned*)hp; win[i] = (f32x2){bflo(v), bfhi(v)}; hp += D; asm volatile("" : "+v"(hp)); }
    } else if (hist_mode == 2) {
        const float* hp = cache_b + c2;
#pragma unroll
        for (int i = 0; i < HIST; ++i) { win[i] = *(const f32x2*)hp; hp += D; asm volatile("" : "+v"(hp)); }
    }
    const bf16* cp = C + (size_t)row0 * D + c2; bf16* op = BB + (size_t)row0 * D + c2;
    unsigned rawA[8], rawB[8];
#pragma unroll
    for (int i = 0; i < 8; ++i) { rawA[i] = *(const unsigned*)(cp + (size_t)i * D); rawB[i] = *(const unsigned*)(cp + (size_t)(8 + i) * D); }
#define CONV_BATCH(RAW, MORE) do { \
        f32x2 dw[8]; float x[16]; \
        _Pragma("unroll") for (int i = 0; i < 8; ++i) { win[HIST + i] = (f32x2){bflo(RAW[i]), bfhi(RAW[i])}; dw[i] = bd; } \
        if (MORE) { _Pragma("unroll") for (int i = 0; i < 8; ++i) RAW[i] = *(const unsigned*)(cp + (size_t)(16 + i) * D); } \
        cp += 8 * D; \
        _Pragma("unroll") for (int j = 0; j < CW; ++j) _Pragma("unroll") for (int i = 0; i < 8; ++i) dw[i] += w[j] * win[i + j]; \
        _Pragma("unroll") for (int i = 0; i < 8; ++i) { x[2 * i] = dw[i].x + dw[i].y; x[2 * i + 1] = dw[i].x * dw[i].x + dw[i].y * dw[i].y; } \
        _Pragma("unroll") for (int i = 0; i < HIST; ++i) win[i] = win[i + 8]; \
          \
        _Pragma("unroll") for (int st = 0; st < 4; ++st) { const int n = 8 >> st, bit = 32 >> st; \
            const unsigned long long upm = st == 0 ? 0xffffffff00000000ull : st == 1 ? 0xffff0000ffff0000ull : st == 2 ? 0xff00ff00ff00ff00ull : 0xf0f0f0f0f0f0f0f0ull; \
            _Pragma("unroll") for (int i = 0; i < n; ++i) { const float keep = lane_sel(upm, x[i], x[i + n]), send = lane_sel(upm, x[i + n], x[i]); x[i] = keep + __shfl_xor(send, bit); } } \
        x[0] += __shfl_xor(x[0], 2); x[0] += __shfl_xor(x[0], 1); \
        LDS_BARRIER(); \
        if ((lane & 3) == 0) wred[wave * 16 + (lane >> 2)] = x[0]; \
        LDS_BARRIER(); \
        if (tid < 16) { float tot = 0.f; \
            _Pragma("unroll") for (int wv = 0; wv < 8; ++wv) tot += wred[wv * 16 + tid]; \
            const float oth = __shfl_xor(tot, 1); \
            if ((tid & 1) == 0) { const float mu = tot * (1.f / D), var = oth * (1.f / D) - mu * mu; ST2[tid] = mu; ST2[tid + 1] = 1.f / sqrtf(var + EPS); } } \
        LDS_BARRIER(); \
        _Pragma("unroll") for (int i = 0; i < 8; ++i) { const f32x2 ms = *(const LAS f32x2*)(ST2 + 2 * i); \
            const float y0 = (dw[i].x - ms.x) * ms.y * gc.x + bc.x, y1 = (dw[i].y - ms.x) * ms.y * gc.y + bc.y; \
            *(unsigned*)(op + (size_t)i * D) = pk2(y0 * sigm(y0), y1 * sigm(y1)); } \
        op += 8 * D; } while (0)
#pragma clang loop unroll(disable)
    for (int base = 0; base < NT; base += 16) { const bool more = base + 16 < NT; CONV_BATCH(rawA, more); CONV_BATCH(rawB, more); }
#undef CONV_BATCH
}
__device__ __forceinline__ void p2_mixers(Frame& F) {
    float* sgv = F.out + (size_t)M * D + 2 * (size_t)DB * HIST * D;
#ifndef P2A_REP
#define P2A_REP 1
#endif
#ifndef P2B_REP
#define P2B_REP 1
#endif
    for (int rep_ = 0; rep_ < P2A_REP; ++rep_)
    for (int it = F.vcu; it < MP / 128 + DB; it += F.G) {
        if (it < MP / 128) sg_item128(F, it * 128); else sg_item32(F, MP + 32 * (it - MP / 128), sgv + (size_t)(it - MP / 128) * DSEQ * D);
    }
    asm volatile("" ::: "memory");
    for (int rep_ = 0; rep_ < P2B_REP; ++rep_)
    for (int it = F.vcu; it < MP / 128 + 2 * DB; it += F.G) {
        if (it < MP / 128) conv_item<128>(F, it * 128, (it & 31) ? 1 : 0, nullptr);
        else if (it >= MP / 128 + DB) { const int b = it - (MP / 128 + DB); conv_item<32>(F, MP + 32 * b, 2, par(F, PO_CACHE) + (size_t)b * HIST * D); }
    }
}
struct SchedStd {
    pg8::StaticOrder so;
    __device__ void init(int nM, int nN, int G, int c) { so.init(nM, nN, G, c); }
    __device__ bool next(int i, pg8::Unit& u) const { return so.next(i, u); }
};
__device__ __forceinline__ void mul8(f32x4& a, f32x4& b, const u32x4 w) {
    a.x *= bflo(w.x); a.y *= bfhi(w.x); a.z *= bflo(w.y); a.w *= bfhi(w.y); b.x *= bflo(w.z); b.y *= bfhi(w.z); b.z *= bflo(w.w); b.w *= bfhi(w.w);
}
struct EpiP3 {
    static constexpr bool PERM = true, HAS_MID = true;
    const bf16 *RR, *SGB; bf16* MIX;
    __device__ __forceinline__ void mid(f32x4 (&acc)[2][2][4][2], const pg8::Unit& u, int wr, int wc, int, int) const {
        const int lane_ = lane_id(), fr = lane_ & 15, fq = lane_ >> 4;
        const int row0 = u.pm * 256 + wr * 64 + fr, col0 = u.pn * 256 + wc * 32 + 8 * fq;
#pragma unroll
        for (int ai = 0; ai < 2; ++ai)
#pragma unroll
            for (int m = 0; m < 4; ++m) { const bf16* rowp = RR + (size_t)(row0 + ai * 128 + m * 16) * D + col0;
#pragma unroll
                for (int bj = 0; bj < 2; ++bj) { const u32x4 w = *(const u32x4*)(rowp + bj * 128); mul8(acc[ai][bj][m][0], acc[ai][bj][m][1], w); }
                if (m & 1) asm volatile("" ::: "memory"); }
    }
    __device__ __forceinline__ void operator()(const f32x4 (&acc)[2][2][4][2], const pg8::Unit& u, int wr, int wc, int, int) const {
        const int lane_ = lane_id(), fr = lane_ & 15, fq = lane_ >> 4;
        const int row0 = u.pm * 256 + wr * 64 + fr, col0 = u.pn * 256 + wc * 32 + 8 * fq;
#pragma unroll
        for (int ai = 0; ai < 2; ++ai)
#pragma unroll
            for (int m = 0; m < 4; ++m) { const size_t off = (size_t)(row0 + ai * 128 + m * 16) * D + col0;
#pragma unroll
                for (int bj = 0; bj < 2; ++bj) { const u32x4 w = *(const u32x4*)(SGB + off + bj * 128); f32x4 a = acc[ai][bj][m][0], b = acc[ai][bj][m][1]; mul8(a, b, w);
                    *(u32x4*)(MIX + off + bj * 128) = pack8(a, b); }
                if (m & 1) asm volatile("" ::: "memory"); }
    }
};
struct EpiP4 {
    static constexpr bool PERM = true, HAS_MID = false;
    const float *xp; bf16* HB; float* HSS;
    __device__ __forceinline__ void mid(f32x4 (&acc)[2][2][4][2], const pg8::Unit& u, int wr, int wc, int, int) const {}
    __device__ __forceinline__ void operator()(const f32x4 (&acc)[2][2][4][2], const pg8::Unit& u, int wr, int wc, int, int) const {
        const int lane_ = lane_id(), fr = lane_ & 15, fq = lane_ >> 4;
        const int row0 = u.pm * 256 + wr * 64 + fr, col0 = u.pn * 256 + wc * 32 + 8 * fq;
#pragma unroll
        for (int ai = 0; ai < 2; ++ai) {
#pragma unroll
            for (int m = 0; m < 4; ++m) { const int row = row0 + ai * 128 + m * 16; const size_t off = (size_t)row * D + col0; const float* xr = xp + off; float ss = 0.f;
#pragma unroll
                for (int bj = 0; bj < 2; ++bj) { const f32x4 h0 = *(const f32x4*)(xr + bj * 128) + acc[ai][bj][m][0], h1 = *(const f32x4*)(xr + bj * 128 + 4) + acc[ai][bj][m][1];
                    *(u32x4*)(HB + off + bj * 128) = pack8(h0, h1);
                    ss += (h0.x * h0.x + h0.y * h0.y) + (h0.z * h0.z + h0.w * h0.w) + (h1.x * h1.x + h1.y * h1.y) + (h1.z * h1.z + h1.w * h1.w); }
                ss += __shfl_xor(ss, 16); ss += __shfl_xor(ss, 32);
                if (fq == 0) HSS[(size_t)row * 16 + u.pn * 4 + wc] = ss; }
            asm volatile("" ::: "memory"); }
    }
};
struct EpiP5 {
    static constexpr bool PERM = true, HAS_MID = false;
    bf16* ACT;
    __device__ __forceinline__ void mid(f32x4 (&acc)[2][2][4][2], const pg8::Unit& u, int wr, int wc, int, int) const {}
    __device__ __forceinline__ void operator()(const f32x4 (&acc)[2][2][4][2], const pg8::Unit& u, int wr, int wc, int, int) const {
        const int lane_ = lane_id(), fr = lane_ & 15, fq = lane_ >> 4;
        const int row0 = u.pm * 256 + wr * 64 + fr, col0 = u.pn * 256 + wc * 32 + 8 * fq;
#pragma unroll
        for (int ai = 0; ai < 2; ++ai)
#pragma unroll
            for (int m = 0; m < 4; ++m) { bf16* rowp = ACT + (size_t)(row0 + ai * 128 + m * 16) * FF + col0;
#pragma unroll
                for (int bj = 0; bj < 2; ++bj) { f32x4 a = acc[ai][bj][m][0], b = acc[ai][bj][m][1];
#pragma unroll
                    for (int e = 0; e < 4; ++e) { const float ra = a[e] > 0.f ? a[e] : 0.f, rb = b[e] > 0.f ? b[e] : 0.f; a[e] = ra * ra; b[e] = rb * rb; }
                    *(u32x4*)(rowp + bj * 128) = pack8(a, b); } }
    }
};
__device__ __forceinline__ float row_ss16(const float* p) {
    const f32x4 a = *(const f32x4*)p, b = *(const f32x4*)(p + 4), c = *(const f32x4*)(p + 8), d = *(const f32x4*)(p + 12);
    return ((a.x + a.y) + (a.z + a.w)) + ((b.x + b.y) + (b.z + b.w)) + ((c.x + c.y) + (c.z + c.w)) + ((d.x + d.y) + (d.z + d.w));
}
struct EpiP6 {
    static constexpr bool PERM = true, HAS_MID = false;
    const bf16* H1; bf16* H2; const float* HSS1; float* HSS2;
    __device__ __forceinline__ void mid(f32x4 (&acc)[2][2][4][2], const pg8::Unit& u, int wr, int wc, int, int) const {}
    __device__ __forceinline__ void operator()(const f32x4 (&acc)[2][2][4][2], const pg8::Unit& u, int wr, int wc, int, int) const {
        const int lane_ = lane_id(), fr = lane_ & 15, fq = lane_ >> 4;
        const int row0 = u.pm * 256 + wr * 64 + fr, col0 = u.pn * 256 + wc * 32 + 8 * fq;
#pragma unroll
        for (int ai = 0; ai < 2; ++ai) {
#pragma unroll
            for (int m = 0; m < 4; ++m) { const int row = row0 + ai * 128 + m * 16; const size_t off = (size_t)row * D + col0; float ss = 0.f;
                const float rinv = 1.f / (row_ss16(HSS1 + (size_t)row * 16) * (1.f / D) + EPS);
#pragma unroll
                for (int bj = 0; bj < 2; ++bj) { const u32x4 w = *(const u32x4*)(H1 + off + bj * 128);
                    f32x4 h0 = acc[ai][bj][m][0] * rinv, h1 = acc[ai][bj][m][1] * rinv;
                    h0.x += bflo(w.x); h0.y += bfhi(w.x); h0.z += bflo(w.y); h0.w += bfhi(w.y); h1.x += bflo(w.z); h1.y += bfhi(w.z); h1.z += bflo(w.w); h1.w += bfhi(w.w);
                    *(u32x4*)(H2 + off + bj * 128) = pack8(h0, h1);
                    ss += (h0.x * h0.x + h0.y * h0.y) + (h0.z * h0.z + h0.w * h0.w) + (h1.x * h1.x + h1.y * h1.y) + (h1.z * h1.z + h1.w * h1.w); }
                ss += __shfl_xor(ss, 16); ss += __shfl_xor(ss, 32);
                if (fq == 0) HSS2[(size_t)row * 16 + u.pn * 4 + wc] = ss; }
            asm volatile("" ::: "memory"); }
    }
};
struct EpiP7 {
    static constexpr bool PERM = true, HAS_MID = true;
    float* H; bf16* PE; const float* HSS2; const bf16* H2;
    __device__ __forceinline__ void mid(f32x4 (&acc)[2][2][4][2], const pg8::Unit& u, int wr, int wc, int, int) const {
        const int lane_ = lane_id(), fr = lane_ & 15, fq = lane_ >> 4;
        const int row0 = u.pm * 256 + wr * 64 + fr, col0 = u.pn * 256 + wc * 32 + 8 * fq;
#pragma unroll
        for (int ai = 0; ai < 2; ++ai)
#pragma unroll
            for (int m = 0; m < 4; ++m) { bf16* rowp = PE + (size_t)(row0 + ai * 128 + m * 16) * D + col0;
#pragma unroll
                for (int bj = 0; bj < 2; ++bj) { *(u32x4*)(rowp + bj * 128) = pack8(acc[ai][bj][m][0], acc[ai][bj][m][1]); acc[ai][bj][m][0] = (f32x4){0.f, 0.f, 0.f, 0.f}; acc[ai][bj][m][1] = (f32x4){0.f, 0.f, 0.f, 0.f}; } }
    }
    __device__ __forceinline__ void operator()(const f32x4 (&acc)[2][2][4][2], const pg8::Unit& u, int wr, int wc, int, int) const {
        const int lane_ = lane_id(), fr = lane_ & 15, fq = lane_ >> 4;
        const int row0 = u.pm * 256 + wr * 64 + fr, col0 = u.pn * 256 + wc * 32 + 8 * fq;
#pragma unroll
        for (int ai = 0; ai < 2; ++ai) {
#pragma unroll
            for (int m = 0; m < 4; ++m) { const int row = row0 + ai * 128 + m * 16; const size_t off = (size_t)row * D + col0;
                const float rs = 1.f / sqrtf(row_ss16(HSS2 + (size_t)row * 16) * (1.f / D) + EPS);
#pragma unroll
                for (int bj = 0; bj < 2; ++bj) { const u32x4 w = *(const u32x4*)(PE + off + bj * 128), hw = *(const u32x4*)(H2 + off + bj * 128); f32x4 g0, g1;
#pragma unroll
                    for (int e = 0; e < 4; ++e) { g0[e] = sigm(rs * acc[ai][bj][m][0][e]); g1[e] = sigm(rs * acc[ai][bj][m][1][e]); }
                    mul8(g0, g1, w);
                    g0.x += bflo(hw.x); g0.y += bfhi(hw.x); g0.z += bflo(hw.y); g0.w += bfhi(hw.y); g1.x += bflo(hw.z); g1.y += bfhi(hw.z); g1.z += bflo(hw.w); g1.w += bfhi(hw.w);
                    *(f32x4*)(H + off + bj * 128) = g0; *(f32x4*)(H + off + bj * 128 + 4) = g1; } }
            asm volatile("" ::: "memory"); }
    }
};
constexpr int PO_SS1 = PO_END, PO_SS2 = PO_END + 256 * 32;
static_assert((size_t)(PO_SS2 + 256 * 32) * 4 <= WS_END - WS_PAR, "PAR region");
template <int NSEG, class Epi>
__device__ __forceinline__ void skinny_tile(Frame& F, const bf16* A0, int lda0, const bf16* B0, int ldb0, int K0, const bf16* A1, int lda1, const bf16* B1, int ldb1, int K1, const Epi& epi) {
    LAS float* red = (LAS float*)F.lds;
    const int lane = F.lane, wave = F.wave, r = lane & 31, h = lane >> 5;
    f32x16 acc0, acc1;
#pragma unroll
    for (int e = 0; e < 16; ++e) { acc0[e] = 0.f; acc1[e] = 0.f; }
    { const int kw = K0 >> 3; const bf16* ap = A0 + (size_t)r * lda0 + wave * kw + 8 * h; const bf16* bp = B0 + (size_t)r * ldb0 + wave * kw + 8 * h;
#pragma unroll 4
      for (int k = 0; k < kw; k += 16) { const bf16x8 a = *(const bf16x8*)(ap + k), b = *(const bf16x8*)(bp + k); acc0 = __builtin_amdgcn_mfma_f32_32x32x16_bf16(a, b, acc0, 0, 0, 0); } }
    if constexpr (NSEG == 2) { const int kw = K1 >> 3; const bf16* ap = A1 + (size_t)r * lda1 + wave * kw + 8 * h; const bf16* bp = B1 + (size_t)r * ldb1 + wave * kw + 8 * h;
#pragma unroll 4
      for (int k = 0; k < kw; k += 16) { const bf16x8 a = *(const bf16x8*)(ap + k), b = *(const bf16x8*)(bp + k); acc1 = __builtin_amdgcn_mfma_f32_32x32x16_bf16(a, b, acc1, 0, 0, 0); } }
#pragma unroll
    for (int e = 0; e < 16; ++e) { const int row = (e & 3) + 8 * (e >> 2) + 4 * h; red[(wave * NSEG) * 1024 + row * 32 + r] = acc0[e]; if constexpr (NSEG == 2) red[(wave * NSEG + 1) * 1024 + row * 32 + r] = acc1[e]; }
    __syncthreads();
    const int row = F.tid >> 4, c0 = 2 * (F.tid & 15);
    float p[2] = {0.f, 0.f}, q[2] = {0.f, 0.f};
#pragma unroll
    for (int w = 0; w < 8; ++w) { const f32x2 t = *(const LAS f32x2*)(red + (w * NSEG) * 1024 + row * 32 + c0); p[0] += t.x; p[1] += t.y;
        if constexpr (NSEG == 2) { const f32x2 t2 = *(const LAS f32x2*)(red + (w * NSEG + 1) * 1024 + row * 32 + c0); q[0] += t2.x; q[1] += t2.y; } }
    epi(row, c0, p, q);
    __syncthreads();
}
__device__ __forceinline__ float sum16(float v) { v += __shfl_xor(v, 1); v += __shfl_xor(v, 2); v += __shfl_xor(v, 4); v += __shfl_xor(v, 8); return v; }
__device__ __forceinline__ float ss_row32(const float* p) { float s = 0.f;
#pragma unroll
    for (int i = 0; i < 32; ++i) s += p[i * 256]; return s; }
__device__ __forceinline__ void s1_sample(Frame& F) {
    const bf16* XN = slot(F, 0); const bf16* WR = wsb(F, WS_WR); const bf16* WV = wsb(F, WS_WV);
    bf16 *U = slot(F, 1), *VT = slot(F, 2), *C = slot(F, 3), *RR = slot(F, 4), *SGB = slot(F, 5); float* css = F.out + (size_t)M * D + (size_t)DB * HIST * D;
    for (int u = F.vcu; u < 8 * 128; u += F.G) {
        const int rb = u & 7, blk = u >> 3, type = blk >> 5, jb = blk & 31, row0 = MP + 32 * rb; const bf16* A = XN + (size_t)row0 * D;
        if (type == 0) skinny_tile<1>(F, A, D, WR + (size_t)(32 * jb) * D, D, D, A, D, WR, D, D, [&](int row, int c0, const float* p, const float*) {
            *(unsigned*)(U + (size_t)(row0 + row) * D + 32 * jb + c0) = pk2(p[0], p[1]); });
        else if (type == 1) skinny_tile<1>(F, A, D, WV + (size_t)(32 * jb) * D, D, D, A, D, WV, D, D, [&](int row, int c0, const float* p, const float*) {
            VT[(size_t)(32 * jb + c0) * M + row0 + row] = (bf16)f2bf(p[0]); VT[(size_t)(32 * jb + c0 + 1) * M + row0 + row] = (bf16)f2bf(p[1]); });
        else { const int wrow = (type == 2 ? 1024 : 3072) + 256 * (jb >> 2) + 32 * (jb & 3);
            const bf16* Ba = WR + (size_t)wrow * D; const bf16* Bb = Ba + (size_t)128 * D;
            if (type == 2) skinny_tile<2>(F, A, D, Ba, D, D, A, D, Bb, D, D, [&](int row, int c0, const float* p, const float* q) {
                const float v0 = p[0] * sigm(q[0]), v1 = p[1] * sigm(q[1]); const int t = row;
                *(unsigned*)(C + (size_t)(row0 + row) * D + 32 * jb + c0) = pk2(v0, v1);
                if (t >= DSEQ - HIST) *(f32x2*)(css + ((size_t)rb * HIST + (t - (DSEQ - HIST))) * D + 32 * jb + c0) = (f32x2){v0, v1}; });
            else skinny_tile<2>(F, A, D, Ba, D, D, A, D, Bb, D, D, [&](int row, int c0, const float* p, const float* q) {
                const float ea0 = __expf(-p[0]), ea1 = __expf(-p[1]), eb0 = __expf(-q[0]), eb1 = __expf(-q[1]); const size_t off = (size_t)(row0 + row) * D + 32 * jb + c0;
                *(unsigned*)(RR + off) = pk2((1.f + eb0) / (1.f + ea0), (1.f + eb1) / (1.f + ea1)); *(unsigned*)(SGB + off) = pk2(1.f / (1.f + eb0), 1.f / (1.f + eb1)); }); }
    }
}
__device__ __forceinline__ void s3_sample(Frame& F) {
    const bf16 *A = slot(F, 0), *BB = slot(F, 6), *RR = slot(F, 4), *SGB = slot(F, 5); bf16* MIX = slot(F, 1);
    for (int u = F.vcu; u < 8 * 32; u += F.G) { const int rb = u & 7, jb = u >> 3, row0 = MP + 32 * rb;
        skinny_tile<2>(F, A + (size_t)row0 * D, D, wsb(F, WS_WA) + (size_t)(32 * jb) * D, D, D, BB + (size_t)row0 * D, D, wsb(F, WS_WB) + (size_t)(32 * jb) * D, D, D, [&](int row, int c0, const float* p, const float* q) {
            const size_t off = (size_t)(row0 + row) * D + 32 * jb + c0; const unsigned rr = *(const unsigned*)(RR + off), sg = *(const unsigned*)(SGB + off);
            *(unsigned*)(MIX + off) = pk2(bflo(sg) * (bflo(rr) * p[0] + q[0]), bfhi(sg) * (bfhi(rr) * p[1] + q[1])); }); }
}
__device__ __forceinline__ void s4_sample(Frame& F, const float* xs) {
    const bf16* MIX = slot(F, 1); bf16* HB = slot(F, 2); float* SS1 = (float*)(F.ws + WS_PAR) + PO_SS1;
    for (int u = F.vcu; u < 8 * 32; u += F.G) { const int rb = u & 7, jb = u >> 3, row0 = MP + 32 * rb;
        skinny_tile<1>(F, MIX + (size_t)row0 * D, D, wsb(F, WS_WO) + (size_t)(32 * jb) * D, D, D, MIX, D, MIX, D, D, [&](int row, int c0, const float* p, const float*) {
            const size_t off = (size_t)(row0 + row) * D + 32 * jb + c0; const f32x2 x = *(const f32x2*)(xs + (size_t)(32 * rb + row) * D + 32 * jb + c0);
            const float h0 = x.x + p[0], h1 = x.y + p[1]; *(unsigned*)(HB + off) = pk2(h0, h1);
            const float ss = sum16(h0 * h0 + h1 * h1); if ((F.tid & 15) == 0) SS1[jb * 256 + 32 * rb + row] = ss; }); }
}
__device__ __forceinline__ void s5_sample(Frame& F) {
    const bf16* HB = slot(F, 2); bf16* ACT = slot(F, 3);
    for (int u = F.vcu; u < 8 * 128; u += F.G) { const int rb = u & 7, jb = u >> 3, row0 = MP + 32 * rb;
        skinny_tile<1>(F, HB + (size_t)row0 * D, D, wsb(F, WS_WUP) + (size_t)(32 * jb) * D, D, D, HB, D, HB, D, D, [&](int row, int c0, const float* p, const float*) {
            const float a = p[0] > 0.f ? p[0] : 0.f, b = p[1] > 0.f ? p[1] : 0.f; *(unsigned*)(ACT + (size_t)(row0 + row) * FF + 32 * jb + c0) = pk2(a * a, b * b); }); }
}
__device__ __forceinline__ void s6_sample(Frame& F) {
    const bf16* ACT = slot(F, 3); const bf16* HB1 = slot(F, 2); bf16* HB2 = slot(F, 0); const float* SS1 = (const float*)(F.ws + WS_PAR) + PO_SS1; float* SS2 = (float*)(F.ws + WS_PAR) + PO_SS2;
    for (int u = F.vcu; u < 8 * 32; u += F.G) { const int rb = u & 7, jb = u >> 3, row0 = MP + 32 * rb;
        skinny_tile<1>(F, ACT + (size_t)row0 * FF, FF, wsb(F, WS_WDN) + (size_t)(32 * jb) * FF, FF, FF, ACT, FF, ACT, FF, FF, [&](int row, int c0, const float* p, const float*) {
            const size_t off = (size_t)(row0 + row) * D + 32 * jb + c0; const float rinv = 1.f / (ss_row32(SS1 + 32 * rb + row) * (1.f / D) + EPS);
            const unsigned hh = *(const unsigned*)(HB1 + off); const float h0 = bflo(hh) + rinv * p[0], h1 = bfhi(hh) + rinv * p[1];
            *(unsigned*)(HB2 + off) = pk2(h0, h1);
            const float ss = sum16(h0 * h0 + h1 * h1); if ((F.tid & 15) == 0) SS2[jb * 256 + 32 * rb + row] = ss; }); }
}
__device__ __forceinline__ void s7_sample(Frame& F) {
    const bf16* HB2 = slot(F, 0); const bf16* PB = wsb(F, WS_PB); const float* SS2 = (const float*)(F.ws + WS_PAR) + PO_SS2;
    for (int u = F.vcu; u < 8 * 32; u += F.G) { const int rb = u & 7, jb = u >> 3, row0 = MP + 32 * rb;
        skinny_tile<2>(F, PB + (size_t)row0 * PLE, PLE, wsb(F, WS_WPL) + (size_t)(32 * jb) * PLE, PLE, PLE, HB2 + (size_t)row0 * D, D, wsb(F, WS_WPG) + (size_t)(32 * jb) * D, D, D, [&](int row, int c0, const float* p, const float* q) {
            const size_t off = (size_t)(row0 + row) * D + 32 * jb + c0; const float rs = 1.f / sqrtf(ss_row32(SS2 + 32 * rb + row) * (1.f / D) + EPS);
            const unsigned hh = *(const unsigned*)(HB2 + off); *(f32x2*)(F.out + off) = (f32x2){bflo(hh) + sigm(rs * q[0]) * p[0], bfhi(hh) + sigm(rs * q[1]) * p[1]}; }); }
}
__device__ __forceinline__ void p8_final(Frame& F) {
    const int gw = F.vcu * NWAVES + F.wave, NGW = F.G * NWAVES, lane = F.lane;
    f32x4 gf[4];
#pragma unroll
    for (int j = 0; j < 4; ++j) gf[j] = *(const f32x4*)(par(F, PO_GFIN) + 4 * lane + 256 * j);
    for (int m = gw; m < M; m += NGW) { float* xr = F.out + (size_t)m * D + 4 * lane; f32x4 v[4]; float s = 0.f;
#pragma unroll
        for (int j = 0; j < 4; ++j) { v[j] = *(const f32x4*)(xr + 256 * j); s += (v[j].x * v[j].x + v[j].y * v[j].y) + (v[j].z * v[j].z + v[j].w * v[j].w); }
        const float rs = 1.f / sqrtf(wave_sum(s) * (1.f / D) + EPS);
#pragma unroll
        for (int j = 0; j < 4; ++j) *(f32x4*)(xr + 256 * j) = v[j] * rs * gf[j]; }
}

constexpr int N_PHASES = 9;
__global__ void __launch_bounds__(NTHR, 2) mega_fwd(Args args) {
    extern __shared__ __attribute__((aligned(16))) unsigned char lds[];
    Frame F;
    F.lds = (LAS unsigned char*)lds;
    F.wave = __builtin_amdgcn_readfirstlane((int)threadIdx.x >> 6); PHASE_IDS(F);
    F.G = gridDim.x; { const int bx = blockIdx.x; F.vcu = (F.G % 8 == 0) ? (bx % 8) * (F.G / 8) + bx / 8 : bx; }
    F.out = args.out; F.ws = args.ws;
    volatile LAS unsigned* MISC = (volatile LAS unsigned*)(F.lds + MISC_OFF);
    for (int u = F.tid; u < (LDS_BYTES - LDSCTL_OFF) / 4; u += NTHR) ((LAS unsigned*)(F.lds + LDSCTL_OFF))[u] = 0u;
    __syncthreads();
    const int lo = args.ph_lo, hi = args.ph_hi;
    XcdBarrier bar; bar.bar = (unsigned*)(F.ws + WS_CTL) + CW_BAR; bar.x = 0; bar.st = nullptr;
    if (hi - lo > 1) bar = xcd_barrier_post((unsigned*)(F.ws + WS_CTL) + CW_BAR, MISC + 8, F.wave == 0 && F.lane == 0);
#ifndef PHASE_MASK
#define PHASE_MASK 0x1ff
#endif
#define IN(k) (((PHASE_MASK >> (k)) & 1) && lo <= (k) && (k) < hi)
#ifndef REPEAT_MASK
#define REPEAT_MASK 0
#endif
#define REP(k) for (int rep_ = 0; rep_ < 1 + ((REPEAT_MASK >> (k)) & 1); ++rep_)
#define SEAM(k) do { if (IN(k) && IN((k) + 1)) xcd_barrier(bar, F.wave == 0 && lane_id() == 0); } while (0)
    float* csp = F.out + (size_t)M * D; float* css = csp + (size_t)DB * HIST * D;
    float* HSS1 = (float*)(F.ws + WS_HSS1); float* HSS2 = (float*)(F.ws + WS_HSS2);
    const char* wbase = (const char*)(F.ws + WS_WR);

    if (IN(0)) { REP(0) { PHASE_IDS(F); p0_prologue(F, args); } SEAM(0); }
    if (IN(1)) { REP(1) {
        pg8::Gemm g{wbase, wbase, wbase, wbase, D, D, D, D, 16, 16}; SchedP1 S; S.init(F.G, (int)blockIdx.x);
        EpiP1 E{slot(F, 1), slot(F, 2), slot(F, 3), slot(F, 4), slot(F, 5), csp, css};
        PHASE_IDS(F); pg8::gemm_phase<EpiP1, SchedP1>(F.lds + RING_OFF, g, S, E, F.tid);
        PHASE_IDS(F); s1_sample(F);
        }
        SEAM(1);
    }
    if (IN(2)) { REP(2) { PHASE_IDS(F); p2_mixers(F); } SEAM(2); }
    if (IN(3)) { REP(3) {
        pg8::Gemm g{(const char*)slot(F, 0), (const char*)slot(F, 6), (const char*)(F.ws + WS_WA), (const char*)(F.ws + WS_WB), D, D, D, D, 32, 16}; SchedStd S; S.init(MP / 256, 4, F.G, (int)blockIdx.x);
        EpiP3 E{slot(F, 4), slot(F, 5), slot(F, 1)};
        PHASE_IDS(F); pg8::gemm_phase<EpiP3, SchedStd>(F.lds + RING_OFF, g, S, E, F.tid);
        PHASE_IDS(F); s3_sample(F);
        }
        SEAM(3);
    }
    if (IN(4)) { REP(4) {
        const char* a = (const char*)slot(F, 1); const char* b = (const char*)(F.ws + WS_WO);
        pg8::Gemm g{a, a, b, b, D, D, D, D, 16, 16}; SchedStd S; S.init(MP / 256, 4, F.G, (int)blockIdx.x);
        EpiP4 E{args.in[0], slot(F, 2), HSS1};
        PHASE_IDS(F); pg8::gemm_phase<EpiP4, SchedStd>(F.lds + RING_OFF, g, S, E, F.tid);
        PHASE_IDS(F); s4_sample(F, args.in[1]);
        }
        SEAM(4);
    }
    if (IN(5)) { REP(5) {
        const char* a = (const char*)slot(F, 2); const char* b = (const char*)(F.ws + WS_WUP);
        pg8::Gemm g{a, a, b, b, D, D, D, D, 16, 16}; SchedStd S; S.init(MP / 256, FF / 256, F.G, (int)blockIdx.x);
        EpiP5 E{slot(F, 3)};
        PHASE_IDS(F); pg8::gemm_phase<EpiP5, SchedStd>(F.lds + RING_OFF, g, S, E, F.tid);
        PHASE_IDS(F); s5_sample(F);
        }
        SEAM(5);
    }
    if (IN(6)) {
        const char* a = (const char*)slot(F, 3); const char* b = (const char*)(F.ws + WS_WDN);
        pg8::Gemm g{a, a, b, b, FF, FF, FF, FF, 64, 64}; SchedStd S; S.init(MP / 256, 4, F.G, (int)blockIdx.x);
        EpiP6 E{slot(F, 2), slot(F, 0), HSS1, HSS2};
        PHASE_IDS(F); pg8::gemm_phase<EpiP6, SchedStd>(F.lds + RING_OFF, g, S, E, F.tid);
        PHASE_IDS(F); s6_sample(F);
        SEAM(6);
    }
    if (IN(7)) {
        pg8::Gemm g{(const char*)(F.ws + WS_PB), (const char*)slot(F, 0), (const char*)(F.ws + WS_WPL), (const char*)(F.ws + WS_WPG), PLE, D, PLE, D, 20, 4}; SchedStd S; S.init(MP / 256, 4, F.G, (int)blockIdx.x);
        EpiP7 E{F.out, slot(F, 1), HSS2, slot(F, 0)};
        PHASE_IDS(F); pg8::gemm_phase<EpiP7, SchedStd, true>(F.lds + RING_OFF, g, S, E, F.tid);
        PHASE_IDS(F); s7_sample(F);
        SEAM(7);
    }
    if (IN(8)) { PHASE_IDS(F); p8_final(F); }
#undef IN
#undef SEAM
}
#ifndef MEGA_HI
#define MEGA_HI 9
#endif
#ifndef ONE_LAUNCH
#define ONE_LAUNCH 1
#endif
#if MEGA_HI < 9
__device__ __forceinline__ float block_sum256(float v, float* sh) {
    for (int o = 1; o < 64; o <<= 1) v += __shfl_xor(v, o);
    __syncthreads(); if ((threadIdx.x & 63) == 0) sh[threadIdx.x >> 6] = v; __syncthreads();
    return sh[0] + sh[1] + sh[2] + sh[3];
}
__global__ void k_rms(const float* __restrict__ X, bf16* __restrict__ O) {
    __shared__ float sh[4];
    const int row = blockIdx.x; const float* x = X + (size_t)row * D; float v[4]; float s = 0.f;
    for (int i = 0; i < 4; ++i) { v[i] = x[threadIdx.x + 256 * i]; s += v[i] * v[i]; }
    s = block_sum256(s, sh); const float rs = 1.f / sqrtf(s / D + EPS);
    for (int i = 0; i < 4; ++i) O[(size_t)row * D + threadIdx.x + 256 * i] = (bf16)f2bf(v[i] * rs);
}
__global__ void k_final(float* __restrict__ H, const float* __restrict__ g) {
    __shared__ float sh[4];
    float* x = H + (size_t)blockIdx.x * D; float v[4]; float s = 0.f;
    for (int i = 0; i < 4; ++i) { v[i] = x[threadIdx.x + 256 * i]; s += v[i] * v[i]; }
    s = block_sum256(s, sh); const float rs = 1.f / sqrtf(s / D + EPS);
    for (int i = 0; i < 4; ++i) x[threadIdx.x + 256 * i] = v[i] * rs * g[threadIdx.x + 256 * i];
}
template <class Epi>
__global__ void __launch_bounds__(256) k_gemm(const bf16* __restrict__ A, int lda, const bf16* __restrict__ Bt, int ldb, int K, Epi epi) {
    const int wave = threadIdx.x >> 6, lane = threadIdx.x & 63, r = lane & 31, h = lane >> 5;
    const int row0 = blockIdx.y * 128 + (wave >> 1) * 64, col0 = blockIdx.x * 128 + (wave & 1) * 64;
    f32x16 acc[2][2];
    for (int i = 0; i < 2; ++i) for (int j = 0; j < 2; ++j) for (int e = 0; e < 16; ++e) acc[i][j][e] = 0.f;
    const bf16* ap = A + (size_t)(row0 + r) * lda + 8 * h; const bf16* bp = Bt + (size_t)(col0 + r) * ldb + 8 * h;
    for (int k0 = 0; k0 < K; k0 += 16) {
        bf16x8 a[2], b[2];
        for (int i = 0; i < 2; ++i) { a[i] = *(const bf16x8*)(ap + (size_t)32 * i * lda + k0); b[i] = *(const bf16x8*)(bp + (size_t)32 * i * ldb + k0); }
        for (int i = 0; i < 2; ++i) for (int j = 0; j < 2; ++j) acc[i][j] = __builtin_amdgcn_mfma_f32_32x32x16_bf16(a[i], b[j], acc[i][j], 0, 0, 0);
    }
    for (int i = 0; i < 2; ++i) for (int j = 0; j < 2; ++j) for (int e = 0; e < 16; ++e)
        epi(row0 + 32 * i + (e & 3) + 8 * (e >> 2) + 4 * h, col0 + 32 * j + r, acc[i][j][e]);
}
struct E3a { const bf16* RR; bf16* T; __device__ void operator()(int row, int col, float v) const { size_t i = (size_t)row * D + col; T[i] = (bf16)f2bf(bf2f(RR[i]) * v); } };
struct E3b { const bf16* SGB; const bf16* T; bf16* MIX; __device__ void operator()(int row, int col, float v) const { size_t i = (size_t)row * D + col; MIX[i] = (bf16)f2bf(bf2f(SGB[i]) * (bf2f(T[i]) + v)); } };
struct E4 { const float* xa; const float* xb; float* H; __device__ void operator()(int row, int col, float v) const {
    const float x = row < MP ? xa[(size_t)row * D + col] : xb[(size_t)(row - MP) * D + col]; H[(size_t)row * D + col] = x + v; } };
struct E5 { bf16* ACT; __device__ void operator()(int row, int col, float v) const { const float r = v > 0.f ? v : 0.f; ACT[(size_t)row * FF + col] = (bf16)f2bf(r * r); } };
struct E6 { float* H; __device__ void operator()(int row, int col, float v) const { H[(size_t)row * D + col] += v; } };
struct E7a { bf16* PE; __device__ void operator()(int row, int col, float v) const { PE[(size_t)row * D + col] = (bf16)f2bf(v); } };
struct E7b { const bf16* PE; float* H; __device__ void operator()(int row, int col, float v) const { size_t i = (size_t)row * D + col; H[i] += sigm(v) * bf2f(PE[i]); } };
#endif

extern "C" void kernel_launch(void* const* d_in, const int* in_sizes, int n_in, void* d_out, int out_size, void* d_ws, size_t ws_size, hipStream_t stream) {
    static int grid = 0;
    if (grid == 0) {
        if (n_in != 25 || in_sizes[0] != MP * D || out_size != M * D + 2 * DB * HIST * D + MS * D || ws_size < WS_END) {
            fprintf(stderr, "kernel_launch: unexpected shapes: n_in %d, in0 %d, out %d, ws %zu (need %zu); nothing launched\n", n_in, n_in > 0 ? in_sizes[0] : -1, out_size, ws_size, (size_t)WS_END); grid = -1; return; }
        int dev = 0, cus = 0, per_cu = 0;
        if (hipGetDevice(&dev) != hipSuccess || hipDeviceGetAttribute(&cus, hipDeviceAttributeMultiprocessorCount, dev) != hipSuccess) { fprintf(stderr, "kernel_launch: device query failed\n"); grid = -1; return; }
        if (hipFuncSetAttribute((const void*)mega_fwd, hipFuncAttributeMaxDynamicSharedMemorySize, LDS_BYTES) != hipSuccess) { fprintf(stderr, "kernel_launch: hipFuncSetAttribute failed\n"); grid = -1; return; }
        if (hipOccupancyMaxActiveBlocksPerMultiprocessor(&per_cu, (const void*)mega_fwd, NTHR, LDS_BYTES) != hipSuccess || per_cu < 1)
            fprintf(stderr, "kernel_launch: note: occupancy query reports %d workgroups per CU\n", per_cu);
        (void)hipGetLastError();
        grid = cus;
    }
    if (grid < 0) return;
    if (hipMemsetAsync((char*)d_ws + WS_CTL, 0, CTL_ZERO_BYTES, stream) != hipSuccess) { fprintf(stderr, "kernel_launch: memset failed\n"); return; }
    Args a{};
    for (int i = 0; i < 25; ++i) a.in[i] = (const float*)d_in[i];
    a.out = (float*)d_out; a.ws = (unsigned char*)d_ws;
#if ONE_LAUNCH
    a.ph_lo = 0; a.ph_hi = MEGA_HI;
    hipLaunchKernelGGL(mega_fwd, dim3(grid), dim3(NTHR), LDS_BYTES, stream, a);
#else
    for (int ph = 0; ph < MEGA_HI; ++ph) { a.ph_lo = ph; a.ph_hi = ph + 1; hipLaunchKernelGGL(mega_fwd, dim3(grid), dim3(NTHR), LDS_BYTES, stream, a); }
#endif
    { const hipError_t le = hipPeekAtLastError(); if (le != hipSuccess) fprintf(stderr, "kernel_launch: launch failed: %s\n", hipGetErrorName(le)); }
#if MEGA_HI < 9
    char* ws = (char*)d_ws; float* H = (float*)d_out;
    auto S = [&](int i) { return (bf16*)(ws + WS_S0 + (size_t)i * SLOT); };
    const float* x_p = (const float*)d_in[0]; const float* x_s = (const float*)d_in[1];
    if (MEGA_HI <= 3) {
        k_gemm<E3a><<<dim3(D / 128, M / 128), 256, 0, stream>>>(S(0), D, (const bf16*)(ws + WS_WA), D, D, E3a{S(4), S(2)});
        k_gemm<E3b><<<dim3(D / 128, M / 128), 256, 0, stream>>>(S(6), D, (const bf16*)(ws + WS_WB), D, D, E3b{S(5), S(2), S(1)});
    }
    if (MEGA_HI <= 4) k_gemm<E4><<<dim3(D / 128, M / 128), 256, 0, stream>>>(S(1), D, (const bf16*)(ws + WS_WO), D, D, E4{x_p, x_s, H});
    if (MEGA_HI <= 5) {
        k_rms<<<M, 256, 0, stream>>>(H, S(2));
        k_gemm<E5><<<dim3(FF / 128, M / 128), 256, 0, stream>>>(S(2), D, (const bf16*)(ws + WS_WUP), D, D, E5{S(3)});
        k_gemm<E6><<<dim3(D / 128, M / 128), 256, 0, stream>>>(S(3), FF, (const bf16*)(ws + WS_WDN), FF, FF, E6{H});
    }
    if (MEGA_HI <= 7) {
        k_rms<<<M, 256, 0, stream>>>(H, S(0));
        k_gemm<E7a><<<dim3(D / 128, M / 128), 256, 0, stream>>>((const bf16*)(ws + WS_PB), PLE, (const bf16*)(ws + WS_WPL), PLE, PLE, E7a{S(1)});
        k_gemm<E7b><<<dim3(D / 128, M / 128), 256, 0, stream>>>(S(0), D, (const bf16*)(ws + WS_WPG), D, D, E7b{S(1), H});
    }
    k_final<<<M, 256, 0, stream>>>(H, (const float*)d_in[24]);
#endif
}
```

```cpp
#define MEGA_HI 9
#define ONE_LAUNCH 1
#include <hip/hip_runtime.h>
#include <cstdio>
#include <cstdint>

#define LAS __attribute__((address_space(3)))
#define GAS __attribute__((address_space(1)))
typedef unsigned short bf16;
typedef short bf16x8 __attribute__((ext_vector_type(8)));
typedef float f32x2 __attribute__((ext_vector_type(2)));
typedef float f32x4 __attribute__((ext_vector_type(4)));
typedef float f32x16 __attribute__((ext_vector_type(16)));
typedef unsigned u32x2 __attribute__((ext_vector_type(2)));
typedef unsigned u32x4 __attribute__((ext_vector_type(4)));

constexpr int D = 1024, NB = 8, SEQ = 4096, DB = 8, DSEQ = 32, MP = NB * SEQ, MS = DB * DSEQ, M = MP + MS;
constexpr int FF = 4096, PLE = 256, INC = 6144, CW = 31, HIST = 30;
constexpr float EPS = 1e-6f;
constexpr int NWAVES = 8, NTHR = 512;

constexpr size_t MiB = 1u << 20;
constexpr size_t WS_CTL = 0, CTL_ZERO_BYTES = 64 * 1024;
constexpr size_t WS_WR = 1 * MiB;
constexpr size_t WS_WV = 11 * MiB;
constexpr size_t WS_WA = 13 * MiB, WS_WB = 15 * MiB, WS_WO = 17 * MiB;
constexpr size_t WS_WUP = 19 * MiB;
constexpr size_t WS_WDN = 27 * MiB;
constexpr size_t WS_WPG = 35 * MiB;
constexpr size_t WS_WPL = 37 * MiB;
constexpr size_t WS_WSG = 37 * MiB + 512 * 1024;
constexpr size_t WS_PB = 38 * MiB;
constexpr size_t SLOT = (size_t)M * D * 2;
constexpr size_t WS_S0 = 55 * MiB;
constexpr size_t WS_HSS1 = WS_S0 + 7 * SLOT;
constexpr size_t WS_HSS2 = WS_HSS1 + (size_t)M * 16 * 4;
constexpr size_t WS_PAR = WS_HSS2 + (size_t)M * 16 * 4;
constexpr size_t WS_END = WS_PAR + 1280 * 1024;
static_assert(WS_END <= 512 * MiB, "d_ws map");
constexpr int TP_WR = 0, TP_WV = 20, TP_XN = (int)((WS_S0 - WS_WR) / (512 * 1024));
static_assert((WS_S0 - WS_WR) % (512 * 1024) == 0 && (WS_WV - WS_WR) == 20 * 512 * 1024, "tile alignment");
constexpr int CW_BAR = 1024;

__device__ __forceinline__ unsigned f2bf(float f) { unsigned u = __builtin_bit_cast(unsigned, f); return (u + 0x7fffu + ((u >> 16) & 1u)) >> 16; }
__device__ __forceinline__ unsigned pk2(float lo, float hi) { unsigned r; asm("v_cvt_pk_bf16_f32 %0, %1, %2" : "=v"(r) : "v"(lo), "v"(hi)); return r; }
__device__ __forceinline__ float bflo(unsigned w) { return __builtin_bit_cast(float, w << 16); }
__device__ __forceinline__ float bfhi(unsigned w) { return __builtin_bit_cast(float, w & 0xffff0000u); }
__device__ __forceinline__ float bf2f(bf16 b) { return __builtin_bit_cast(float, (unsigned)b << 16); }
__device__ __forceinline__ float sigm(float x) { return 1.f / (1.f + __expf(-x)); }
#define LDS_WAIT() asm volatile("s_waitcnt lgkmcnt(0)" ::: "memory")
#define VM_WAIT() asm volatile("s_waitcnt vmcnt(0)" ::: "memory")

namespace pg8 {
constexpr int BM = 256, BK = 64, HALF = 128, HTB = HALF * BK * 2, STAGE_BYTES = 8 * HTB, NXCD = 8, WGM = 8;
__host__ __device__ __forceinline__ int lds_byte(int r, int c) { const int st = (r >> 4) * 2 + (c >> 5), rr = r & 15, cc = c & 31, ob = rr * 64 + cc * 2; return st * 1024 + (ob ^ (((ob >> 9) & 1) << 5)); }
__host__ __device__ __forceinline__ void stage_rc(int b, int& R, int& C) { const int st = b / 1024, sb = b % 1024, swz = sb ^ (((sb >> 9) & 1) << 5); R = (st >> 1) * 16 + swz / 64; C = (st & 1) * 32 + (swz % 64) / 2; }
__host__ __device__ __forceinline__ int perm32(int rho) { const int n = rho >> 4, i = rho & 15; return 8 * (i >> 2) + 4 * n + (i & 3); }

struct Unit { int pm, pn; };
struct Gemm { const char* A0; const char* A1; const char* B0; const char* B1; int lda0, lda1, ldb0, ldb1, nt, ts; };

struct StaticOrder {
    int nM, nN, nwg, G, c;
    __device__ void init(int nM_, int nN_, int G_, int c_) { nM = nM_; nN = nN_; nwg = nM * nN; G = G_; c = c_; }
    __device__ bool next(int i, Unit& u) const {
        const long L = (long)i * G + c; if (L >= nwg) return false;
        int wgid = (int)L; { const int q = nwg / NXCD, r = nwg % NXCD, xcd = wgid % NXCD, off = wgid / NXCD; wgid = (xcd < r ? xcd * (q + 1) : r * (q + 1) + (xcd - r) * q) + off; }
        const int nig = WGM * nN, gid = wgid / nig, fm = gid * WGM, gsz = (nM - fm) < WGM ? (nM - fm) : WGM;
        u.pm = fm + ((wgid % nig) % gsz); u.pn = (wgid % nig) / gsz; return true;
    }
};

template <class Epi, class Sched, bool DIFFLD = false>
__device__ __forceinline__ void gemm_phase(LAS unsigned char* lds, const Gemm g, const Sched& S, const Epi& E, const int tid) {
    const int wid = __builtin_amdgcn_readfirstlane(tid >> 6), lane = tid & 63, wr = wid >> 2, wc = wid & 3, fr = lane & 15, fq = lane >> 4;
    const int nt = g.nt, ts = g.ts;
    int R, C; stage_rc(tid * 16, R, C); const int Rb = Epi::PERM ? ((R & ~31) + perm32(R & 31)) : R;
    const unsigned vA0 = (unsigned)(R * g.lda0 + C) * 2u, vB0 = (unsigned)(Rb * g.ldb0 + C) * 2u;
    const unsigned rc = (unsigned)R | ((unsigned)Rb << 8) | ((unsigned)(2 * C) << 16);
    const size_t hA0 = (size_t)HALF * g.lda0 * 2, hA1 = (size_t)HALF * g.lda1 * 2, hB0 = (size_t)HALF * g.ldb0 * 2, hB1 = (size_t)HALF * g.ldb1 * 2;
    const unsigned ldsw = (unsigned)wid * 1024u;
    const int aoff = lds_byte(wr * 64 + fr, fq * 8), boff = lds_byte(wc * 32 + fr, fq * 8);
#define PG8_SA(b, h) (((b) * 2 + (h)) * HTB)
#define PG8_SB(b, h) ((4 + (b) * 2 + (h)) * HTB)
#define PG8_STAGE(bufoff, gbase, voff, hstep) do { \
        __builtin_amdgcn_global_load_lds((const unsigned*)((const char*)(gbase) + (voff)), (LAS unsigned*)(lds + (bufoff) + ldsw), 16, 0, 0); \
        __builtin_amdgcn_global_load_lds((const unsigned*)((const char*)(gbase) + ((hstep) >> 1) + (voff)), (LAS unsigned*)(lds + (bufoff) + ldsw + 8192), 16, 0, 0); } while (0)
#define PG8_LDA(dst, b, h) do { _Pragma("unroll") for (int m = 0; m < 4; ++m) _Pragma("unroll") for (int k = 0; k < 2; ++k) dst[m][k] = *(const LAS bf16x8*)(lds + PG8_SA(b, h) + aoff + m * 2048 + k * 1024); } while (0)
#define PG8_LDB(dst, b, h) do { _Pragma("unroll") for (int n = 0; n < 2; ++n) _Pragma("unroll") for (int k = 0; k < 2; ++k) dst[n][k] = *(const LAS bf16x8*)(lds + PG8_SB(b, h) + boff + n * 2048 + k * 1024); } while (0)
#define PG8_MMA(ai, bj, At, Bt) do { __builtin_amdgcn_s_setprio(1); _Pragma("unroll") for (int m = 0; m < 4; ++m) _Pragma("unroll") for (int n = 0; n < 2; ++n) _Pragma("unroll") for (int k = 0; k < 2; ++k) \
        acc[ai][bj][m][n] = __builtin_amdgcn_mfma_f32_16x16x32_bf16(Bt[n][k], At[m][k], acc[ai][bj][m][n], 0, 0, 0); __builtin_amdgcn_s_setprio(0); } while (0)
#define PG8_WAIT_V(n) asm volatile("s_waitcnt vmcnt(" #n ")" ::: "memory")
#define PG8_WAIT_L(n) asm volatile("s_waitcnt lgkmcnt(" #n ")" ::: "memory")
#define PG8_BAR __builtin_amdgcn_s_barrier()
#define PG8_SCHED __builtin_amdgcn_sched_barrier(0)
    Unit cur, nxt; int ui = 0;
    if (!S.next(0, cur)) return;
    f32x4 acc[2][2][4][2];
#pragma unroll
    for (int a = 0; a < 2; ++a)
#pragma unroll
        for (int b = 0; b < 2; ++b)
#pragma unroll
            for (int m = 0; m < 4; ++m)
#pragma unroll
                for (int n = 0; n < 2; ++n) acc[a][b][m][n] = (f32x4){0.f, 0.f, 0.f, 0.f};
    bf16x8 At[4][2], B0[2][2], B1[2][2];
    {
        const char* cA = g.A0 + (size_t)cur.pm * (2 * hA0); const char* cB = g.B0 + (size_t)cur.pn * (2 * hB0);
        PG8_STAGE(PG8_SB(0, 0), cB, vB0, hB0); PG8_STAGE(PG8_SB(0, 1), cB + hB0, vB0, hB0); PG8_STAGE(PG8_SA(0, 0), cA, vA0, hA0); PG8_STAGE(PG8_SA(0, 1), cA + hA0, vA0, hA0);
        if (wr == 1) PG8_BAR;
        PG8_WAIT_V(2); PG8_BAR;
        PG8_STAGE(PG8_SB(1, 0), cB + 128, vB0, hB0); PG8_STAGE(PG8_SA(1, 0), cA + 128, vA0, hA0); PG8_STAGE(PG8_SB(1, 1), cB + hB0 + 128, vB0, hB0);
        PG8_WAIT_V(6); PG8_BAR;
    }
    for (;;) {
        const bool has_next = S.next(ui + 1, nxt);
        for (int t = 0; t < nt; t += 2) {
            if constexpr (Epi::HAS_MID) { if (t == ts) E.mid(acc, cur, wr, wc, fr, fq); }
            const bool last = (t == nt - 2);
            const bool sc = t >= ts;
            const char* a1 = sc ? g.A1 + (size_t)cur.pm * (2 * hA1) + (size_t)(t + 1 - ts) * 128 : g.A0 + (size_t)cur.pm * (2 * hA0) + (size_t)(t + 1) * 128;
            unsigned vAc = vA0; if constexpr (DIFFLD) { if (sc) vAc = (rc & 0xffu) * (unsigned)(2 * g.lda1) + (rc >> 16); }
            const size_t hAc = sc ? hA1 : hA0;
            const int upm = (last && has_next) ? nxt.pm : cur.pm, upn = (last && has_next) ? nxt.pn : cur.pn, tt = last ? 0 : t + 2;
            const bool sn = tt >= ts;
            const char* a2 = sn ? g.A1 + (size_t)upm * (2 * hA1) + (size_t)(tt - ts) * 128 : g.A0 + (size_t)upm * (2 * hA0) + (size_t)tt * 128;
            const char* b2 = sn ? g.B1 + (size_t)upn * (2 * hB1) + (size_t)(tt - ts) * 128 : g.B0 + (size_t)upn * (2 * hB0) + (size_t)tt * 128;
            unsigned vAn = vA0, vBn = vB0; if constexpr (DIFFLD) { if (sn) { vAn = (rc & 0xffu) * (unsigned)(2 * g.lda1) + (rc >> 16); vBn = ((rc >> 8) & 0xffu) * (unsigned)(2 * g.ldb1) + (rc >> 16); } }
            const size_t hAn = sn ? hA1 : hA0, hBn = sn ? hB1 : hB0;
            const char* a3 = a2 + 128; const char* b3 = b2 + 128;
            PG8_LDB(B0, 0, 0); PG8_LDB(B1, 0, 1); PG8_SCHED; PG8_LDA(At, 0, 0); PG8_STAGE(PG8_SA(1, 1), a1 + hAc, vAc, hAc);
            PG8_WAIT_V(8); PG8_WAIT_L(0); PG8_BAR; PG8_MMA(0, 0, At, B0); PG8_MMA(0, 1, At, B1); PG8_BAR; PG8_SCHED;
            PG8_LDA(At, 0, 1); PG8_STAGE(PG8_SB(0, 0), b2, vBn, hBn); PG8_STAGE(PG8_SB(0, 1), b2 + hBn, vBn, hBn); PG8_STAGE(PG8_SA(0, 0), a2, vAn, hAn);
            PG8_WAIT_V(8); PG8_WAIT_L(0); PG8_BAR; PG8_MMA(1, 0, At, B0); PG8_MMA(1, 1, At, B1); PG8_BAR; PG8_SCHED;
            PG8_LDB(B0, 1, 0); PG8_LDB(B1, 1, 1); PG8_SCHED; PG8_LDA(At, 1, 0); PG8_STAGE(PG8_SA(0, 1), a2 + hAn, vAn, hAn);
            PG8_WAIT_V(8); PG8_WAIT_L(0); PG8_BAR; PG8_MMA(0, 0, At, B0); PG8_MMA(0, 1, At, B1); PG8_BAR; PG8_SCHED;
            PG8_LDA(At, 1, 1); PG8_STAGE(PG8_SB(1, 0), b3, vBn, hBn); PG8_STAGE(PG8_SB(1, 1), b3 + hBn, vBn, hBn); PG8_STAGE(PG8_SA(1, 0), a3, vAn, hAn);
            PG8_WAIT_V(8); PG8_WAIT_L(0); PG8_BAR; PG8_MMA(1, 0, At, B0); PG8_MMA(1, 1, At, B1); PG8_BAR; PG8_SCHED;
        }
        if (wr == 0) PG8_BAR;
        E(acc, cur, wr, wc, fr, fq);
        if (!has_next) break;
#pragma unroll
        for (int a = 0; a < 2; ++a)
#pragma unroll
            for (int b = 0; b < 2; ++b)
#pragma unroll
                for (int m = 0; m < 4; ++m)
#pragma unroll
                    for (int n = 0; n < 2; ++n) acc[a][b][m][n] = (f32x4){0.f, 0.f, 0.f, 0.f};
        cur = nxt; ++ui;
        if (wr == 1) PG8_BAR;
    }
    PG8_WAIT_V(0);
    PG8_BAR;
#undef PG8_SA
#undef PG8_SB
#undef PG8_STAGE
#undef PG8_LDA
#undef PG8_LDB
#undef PG8_MMA
#undef PG8_WAIT_V
#undef PG8_WAIT_L
#undef PG8_BAR
#undef PG8_SCHED
}
}
constexpr int RING_OFF = 0, RING_BYTES = 131072;
constexpr int LDSCTL_OFF = RING_BYTES, MISC_OFF = LDSCTL_OFF + 320;
constexpr int LDS_BYTES = 147456;
static_assert(MISC_OFF + 128 <= LDS_BYTES, "LDS map");

#define XB_TMO      128
#define XB_XCNT(j)  (256  + 64 * (j))
#define XB_XSUB(j)  (1280 + 64 * (j))
#define XB_XGEN(j)  (2304 + 64 * (j))
#define XB_TOP      3328
#define XB_TOPGEN   3392
#define XCD_BAR_WORDS 3456
#define XB_SPIN_CAP (1u << 18)
__device__ __forceinline__ unsigned xb_ld(unsigned* p)              { return __hip_atomic_load(p, __ATOMIC_RELAXED, __HIP_MEMORY_SCOPE_AGENT); }
__device__ __forceinline__ unsigned xb_add(unsigned* p, unsigned v) { return __hip_atomic_fetch_add(p, v, __ATOMIC_RELAXED, __HIP_MEMORY_SCOPE_AGENT); }
__device__ __forceinline__ unsigned xb_xcc_id() { return (unsigned)__builtin_amdgcn_s_getreg((3 << 11) | 20) & 0xFu; }
#define XB_SPIN(cond, bar) do { unsigned _sp = 0; while (cond) { __builtin_amdgcn_s_sleep(1); \
    if ((++_sp & 255u) == 0u) { if (xb_ld(&(bar)[XB_TMO])) break; if (_sp > XB_SPIN_CAP) { atomicAdd(&(bar)[XB_TMO], 1u); break; } } } } while (0)
struct XcdBarrier { unsigned* bar; unsigned x; volatile LAS unsigned* st; };
__device__ __forceinline__ XcdBarrier xcd_barrier_post(unsigned* bar, volatile LAS unsigned* st, const bool leader) {
    XcdBarrier b; b.bar = bar; b.x = xb_xcc_id(); b.st = st;
    if (leader) (void)xb_add(&bar[XB_XCNT(b.x)], 1u);
    return b;
}
__device__ __forceinline__ void xcd_barrier_complete(unsigned* bar, unsigned x, unsigned& nloc, unsigned& nx) {
    const unsigned G = gridDim.x * gridDim.y * gridDim.z;
    unsigned sum, cnt, mine, sp = 0u;
    for (;;) {
        sum = 0u; cnt = 0u; mine = 0u;
#pragma unroll
        for (unsigned j = 0; j < 16; ++j) { const unsigned c = xb_ld(&bar[XB_XCNT(j)]); sum += c; cnt += (c > 0u) ? 1u : 0u; mine = (j == x) ? c : mine; }
        if (sum == G) break;
        __builtin_amdgcn_s_sleep(1);
        if ((++sp & 255u) == 0u) { if (xb_ld(&bar[XB_TMO])) break; if (sp > XB_SPIN_CAP) { atomicAdd(&bar[XB_TMO], 1u); break; } }
    }
    nloc = mine > 0u ? mine : 1u; nx = cnt > 0u ? cnt : 1u;
}
__device__ __forceinline__ void xcd_barrier(const XcdBarrier& b, const bool leader  ) {
    asm volatile("s_waitcnt vmcnt(0)" ::: "memory");
    __syncthreads();
    if (leader) {
        unsigned* bar = b.bar;
        __builtin_amdgcn_s_waitcnt(0);
        unsigned nloc = b.st[0], nx = b.st[1];
        if (nloc == 0u) { xcd_barrier_complete(bar, b.x, nloc, nx); b.st[0] = nloc; b.st[1] = nx; }
        const unsigned old = xb_add(&bar[XB_XSUB(b.x)], 1u);
        const unsigned gen = old / nloc;
        if (old + 1u == (gen + 1u) * nloc) {
            __builtin_amdgcn_fence(__ATOMIC_RELEASE, "agent");
            asm volatile("s_waitcnt vmcnt(0)" ::: "memory");
            const unsigned og = xb_add(&bar[XB_TOP], 1u);
            const unsigned tg = og / nx;
            if (og + 1u == (tg + 1u) * nx) xb_add(&bar[XB_TOPGEN], 1u);
            else XB_SPIN(xb_ld(&bar[XB_TOPGEN]) == tg, bar);
            __builtin_amdgcn_fence(__ATOMIC_ACQUIRE, "agent");
            xb_add(&bar[XB_XGEN(b.x)], 1u);
            asm volatile("s_waitcnt vmcnt(0)" ::: "memory");
        } else {
            XB_SPIN(xb_ld(&bar[XB_XGEN(b.x)]) == gen, bar);
            __builtin_amdgcn_fence(__ATOMIC_ACQUIRE, "agent");
            asm volatile("s_waitcnt vmcnt(0)" ::: "memory");
        }
    }
    __syncthreads();
}

struct Frame {
    LAS unsigned char* lds;
    int tid, lane, wave, G, vcu;
    float* out; unsigned char* ws;
};
struct Args { const float* in[25]; float* out; unsigned char* ws; int ph_lo, ph_hi; };
constexpr int PO_GSGV = 0, PO_BSGV = 1024, PO_BSG = 2048, PO_BDW = 3072, PO_GCLN = 4096, PO_BCLN = 5120, PO_GFIN = 6144, PO_WDW = 7168, PO_CACHE = PO_WDW + CW * D, PO_END = PO_CACHE + DB * HIST * D;
constexpr int PO_SVST = PO_END + 2 * 256 * 32;
__device__ __forceinline__ const float* par(const Frame& F, int off) { return (const float*)(F.ws + WS_PAR) + off; }
__device__ __forceinline__ int lane_id() { int l; asm volatile("v_mbcnt_lo_u32_b32 %0, -1, 0\n\tv_mbcnt_hi_u32_b32 %0, -1, %0" : "=v"(l)); return l; }
#define PHASE_IDS(F) do { (F).lane = lane_id(); (F).tid = (F).wave * 64 + (F).lane; } while (0)
__device__ __forceinline__ bf16* wsb(const Frame& F, size_t off) { return (bf16*)(F.ws + off); }
__device__ __forceinline__ bf16* slot(const Frame& F, int i) { return (bf16*)(F.ws + WS_S0 + (size_t)i * SLOT); }
__device__ __forceinline__ float wave_sum(float v) {
#pragma unroll
    for (int o = 1; o < 64; o <<= 1) v += __shfl_xor(v, o);
    return v;
}

__device__ __forceinline__ float lane_sel(unsigned long long m, float a, float b) { float r; asm("v_cndmask_b32_e64 %0, %1, %2, %3" : "=v"(r) : "v"(a), "v"(b), "s"(m)); return r; }
__device__ __forceinline__ void tr_item(const float* W, int Nsrc, int K, int k0, int s0, const float* gk, bf16* WT, int d0, LAS float* scr, int lane) {
#pragma unroll 8
    for (int i = 0; i < 32; ++i) { const int kk = 2 * i + (lane >> 5); float v = W[(size_t)(k0 + kk) * Nsrc + s0 + (lane & 31)]; if (gk) v *= gk[k0 + kk]; scr[kk * 33 + (lane & 31)] = v; }
    LDS_WAIT(); asm volatile("" ::: "memory");
    const int c = lane & 7;
#pragma unroll
    for (int j = 0; j < 4; ++j) { const int n = (lane >> 3) + 8 * j; const LAS float* s = scr + (8 * c) * 33 + n;
        u32x4 o; o.x = pk2(s[0 * 33], s[1 * 33]); o.y = pk2(s[2 * 33], s[3 * 33]); o.z = pk2(s[4 * 33], s[5 * 33]); o.w = pk2(s[6 * 33], s[7 * 33]);
        *(u32x4*)(WT + (size_t)(d0 + n) * K + k0 + 8 * c) = o; }
    LDS_WAIT(); asm volatile("" ::: "memory");
}
__device__ __forceinline__ int wr_src_col(int d) {
    if (d < 1024) return d;
    const int base = d < 3072 ? 2048 : 4096, e = d < 3072 ? d - 1024 : d - 3072;
    return base + 1024 * ((e >> 7) & 1) + 128 * (e >> 8) + (e & 127);
}
__device__ __forceinline__ void p0_prologue(Frame& F, const Args& A) {
    LAS float* scr = (LAS float*)(F.lds + RING_OFF + F.wave * 16384);
    const int gw = F.vcu * NWAVES + F.wave, NGW = F.G * NWAVES, lane = F.lane;
    constexpr int I_WR = 16 * 160, I_WV = 16 * 32, I_SQ = 16 * 32, I_UP = 16 * 128, I_DN = 64 * 32, I_PL = 4 * 32;
    constexpr int NITEMS = I_WR + I_WV + 4 * I_SQ + I_UP + I_DN + I_PL;
    for (int it = gw; it < NITEMS; it += NGW) {
        int r = it;
        if (r < I_WR) { const int kb = r / 160, nb = r % 160; tr_item(A.in[6], INC, D, 64 * kb, wr_src_col(32 * nb), nullptr, wsb(F, WS_WR), 32 * nb, scr, lane); continue; } r -= I_WR;
        if (r < I_WV) { const int kb = r / 32, nb = r % 32; tr_item(A.in[6], INC, D, 64 * kb, 1024 + 32 * nb, nullptr, wsb(F, WS_WV), 32 * nb, scr, lane); continue; } r -= I_WV;
        if (r < I_SQ) { const int kb = r / 32, nb = r % 32; tr_item(A.in[11], D, D, 64 * kb, 32 * nb, nullptr, wsb(F, WS_WA), 32 * nb, scr, lane); continue; } r -= I_SQ;
        if (r < I_SQ) { const int kb = r / 32, nb = r % 32; tr_item(A.in[16], D, D, 64 * kb, 32 * nb, nullptr, wsb(F, WS_WB), 32 * nb, scr, lane); continue; } r -= I_SQ;
        if (r < I_SQ) { const int kb = r / 32, nb = r % 32; tr_item(A.in[17], D, D, 64 * kb, 32 * nb, nullptr, wsb(F, WS_WO), 32 * nb, scr, lane); continue; } r -= I_SQ;
        if (r < I_SQ) { const int kb = r / 32, nb = r % 32; tr_item(A.in[22], D, D, 64 * kb, 32 * nb, A.in[21], wsb(F, WS_WPG), 32 * nb, scr, lane); continue; } r -= I_SQ;
        if (r < I_UP) { const int kb = r / 128, nb = r % 128; tr_item(A.in[19], FF, D, 64 * kb, 32 * nb, A.in[18], wsb(F, WS_WUP), 32 * nb, scr, lane); continue; } r -= I_UP;
        if (r < I_DN) { const int kb = r / 32, nb = r % 32; tr_item(A.in[20], D, FF, 64 * kb, 32 * nb, nullptr, wsb(F, WS_WDN), 32 * nb, scr, lane); continue; } r -= I_DN;
        { const int kb = r / 32, nb = r % 32; tr_item(A.in[23], D, PLE, 64 * kb, 32 * nb, nullptr, wsb(F, WS_WPL), 32 * nb, scr, lane); }
    }
    for (int rr = gw; rr < 8 * 128 / 2; rr += NGW) { const int row = 2 * rr + (lane >> 5), t = row & 127, s0 = 4 * (lane & 31);
        const f32x4 w = *(const f32x4*)(A.in[9] + (size_t)row * 128 + s0); u32x2 o;
        o.x = pk2(s0 + 0 <= t ? w.x : 0.f, s0 + 1 <= t ? w.y : 0.f); o.y = pk2(s0 + 2 <= t ? w.z : 0.f, s0 + 3 <= t ? w.w : 0.f);
        *(u32x2*)(wsb(F, WS_WSG) + (size_t)row * 128 + s0) = o; }
    { float* P = (float*)(F.ws + WS_PAR); const int gt = gw * 64 + lane, NT_ = NGW * 64;
      for (int i = gt; i < PO_END / 4; i += NT_) { const int o = 4 * i; const float* src;
          if (o < PO_BSGV) src = A.in[7] + o; else if (o < PO_BSG) src = A.in[8] + (o - PO_BSGV); else if (o < PO_BDW) src = A.in[10] + (o - PO_BSG); else if (o < PO_GCLN) src = A.in[13] + (o - PO_BDW);
          else if (o < PO_BCLN) src = A.in[14] + (o - PO_GCLN); else if (o < PO_GFIN) src = A.in[15] + (o - PO_BCLN); else if (o < PO_WDW) src = A.in[24] + (o - PO_GFIN);
          else if (o < PO_CACHE) src = A.in[12] + (o - PO_WDW); else src = A.in[2] + (o - PO_CACHE);
          *(f32x4*)(P + o) = *(const f32x4*)src; } }
    bf16* XN = slot(F, 0); bf16* PB = wsb(F, WS_PB);
    f32x4 gm[4];
#pragma unroll
    for (int j = 0; j < 4; ++j) gm[j] = *(const f32x4*)(A.in[5] + 4 * lane + 256 * j);
    for (int m = gw; m < M; m += NGW) {
        const float* xr = m < MP ? A.in[0] + (size_t)m * D : A.in[1] + (size_t)(m - MP) * D;
        const float* pr = m < MP ? A.in[3] + (size_t)m * PLE : A.in[4] + (size_t)(m - MP) * PLE;
        f32x4 v[4]; float s = 0.f;
#pragma unroll
        for (int j = 0; j < 4; ++j) { v[j] = *(const f32x4*)(xr + 4 * lane + 256 * j); s += (v[j].x * v[j].x + v[j].y * v[j].y) + (v[j].z * v[j].z + v[j].w * v[j].w); }
        const f32x4 pv = *(const f32x4*)(pr + 4 * lane);
        const float rs = 1.f / sqrtf(wave_sum(s) * (1.f / D) + EPS);
#pragma unroll
        for (int j = 0; j < 4; ++j) { u32x2 o; o.x = pk2(v[j].x * rs * gm[j].x, v[j].y * rs * gm[j].y); o.y = pk2(v[j].z * rs * gm[j].z, v[j].w * rs * gm[j].w);
            *(u32x2*)(XN + (size_t)m * D + 4 * lane + 256 * j) = o; }
        u32x2 po; po.x = pk2(pv.x, pv.y); po.y = pk2(pv.z, pv.w); *(u32x2*)(PB + (size_t)m * PLE + 4 * lane) = po;
    }
}

struct SchedP1 {
    pg8::StaticOrder so;
    __device__ void init(int G, int c) { so.init(MP / 256, 24, G, c); }
    __device__ bool next(int i, pg8::Unit& u) const {
        pg8::Unit v; if (!so.next(i, v)) return false;
        if (v.pn < 20) { u.pm = TP_XN + v.pm; u.pn = TP_WR + v.pn; } else { u.pm = TP_WV + (v.pn - 20); u.pn = TP_XN + v.pm; }
        return true;
    }
};
__device__ __forceinline__ u32x4 pack8(const f32x4 a, const f32x4 b) { u32x4 w; w.x = pk2(a.x, a.y); w.y = pk2(a.z, a.w); w.z = pk2(b.x, b.y); w.w = pk2(b.z, b.w); return w; }
struct EpiP1 {
    static constexpr bool PERM = true, HAS_MID = false; static constexpr int TRAIL = 8;
    bf16 *U, *VT, *C, *RR, *SGB; float *csp, *css, *VST;
    __device__ __forceinline__ void mid(f32x4 (&acc)[2][2][4][2], const pg8::Unit& u, int wr, int wc, int, int) const {}
    __device__ __forceinline__ void operator()(const f32x4 (&acc)[2][2][4][2], const pg8::Unit& u, int wr, int wc, int, int) const {
        const int lane_ = lane_id(), fr = lane_ & 15, fq = lane_ >> 4;
        if (u.pm >= TP_WV && u.pm < TP_WV + 4) {
            const int ch0 = (u.pm - TP_WV) * 256 + wr * 64 + fr, tok0 = (u.pn - TP_XN) * 256 + wc * 32 + 8 * fq;
#pragma unroll
            for (int ai = 0; ai < 2; ++ai)
#pragma unroll
                for (int m = 0; m < 4; ++m) { bf16* rowp = VT + (size_t)(ch0 + ai * 128 + m * 16) * M + tok0;
#pragma unroll
                    for (int bj = 0; bj < 2; ++bj) *(u32x4*)(rowp + bj * 128) = pack8(acc[ai][bj][m][0], acc[ai][bj][m][1]); }
            float x[32];
#pragma unroll
            for (int i = 0; i < 32; ++i) x[i] = 0.f;
#pragma unroll
            for (int ai = 0; ai < 2; ++ai)
#pragma unroll
                for (int m = 0; m < 4; ++m)
#pragma unroll
                    for (int bj = 0; bj < 2; ++bj)
#pragma unroll
                        for (int n = 0; n < 2; ++n)
#pragma unroll
                            for (int e = 0; e < 4; ++e) { const float v = acc[ai][bj][m][n][e]; x[2 * (8 * bj + 4 * n + e)] += v; x[2 * (8 * bj + 4 * n + e) + 1] += v * v; }
#pragma unroll
            for (int st = 0; st < 4; ++st) { const int n = 16 >> st, bit = 8 >> st;
                const unsigned long long upm = st == 0 ? 0xff00ff00ff00ff00ull : st == 1 ? 0xf0f0f0f0f0f0f0f0ull : st == 2 ? 0xccccccccccccccccull : 0xaaaaaaaaaaaaaaaaull;
#pragma unroll
                for (int i = 0; i < n; ++i) { const float keep = lane_sel(upm, x[i], x[i + n]), send = lane_sel(upm, x[i + n], x[i]); x[i] = keep + __shfl_xor(send, bit); } }
            const int tok = (u.pn - TP_XN) * 256 + 128 * (fr >> 3) + wc * 32 + 8 * fq + (fr & 7), part = (u.pm - TP_WV) * 2 + wr;
            *(f32x2*)(VST + ((size_t)part * M + tok) * 2) = (f32x2){x[0], x[1]};
            return;
        }
        const int row0 = (u.pm - TP_XN) * 256 + wr * 64 + fr, j = u.pn - TP_WR;
        if (j < 4) {
            const int col0 = j * 256 + wc * 32 + 8 * fq;
#pragma unroll
            for (int ai = 0; ai < 2; ++ai)
#pragma unroll
                for (int m = 0; m < 4; ++m) { bf16* rowp = U + (size_t)(row0 + ai * 128 + m * 16) * D + col0;
#pragma unroll
                    for (int bj = 0; bj < 2; ++bj) *(u32x4*)(rowp + bj * 128) = pack8(acc[ai][bj][m][0], acc[ai][bj][m][1]); }
        } else if (j < 12) {
            const int ch0 = (j - 4) * 128 + wc * 32 + 8 * fq;
#pragma unroll
            for (int ai = 0; ai < 2; ++ai)
#pragma unroll
                for (int m = 0; m < 4; ++m) { const int row = row0 + ai * 128 + m * 16; f32x4 c0, c1;
#pragma unroll
                    for (int e = 0; e < 4; ++e) { c0[e] = acc[ai][0][m][0][e] * sigm(acc[ai][1][m][0][e]); c1[e] = acc[ai][0][m][1][e] * sigm(acc[ai][1][m][1][e]); }
                    *(u32x4*)(C + (size_t)row * D + ch0) = pack8(c0, c1);
                    float* cs = nullptr;
                    if (row < MP) { const int t = row & (SEQ - 1); if (t >= SEQ - HIST) cs = csp + ((size_t)(row >> 12) * HIST + (t - (SEQ - HIST))) * D; }
                    else { const int rr = row - MP, t = rr & (DSEQ - 1); if (t >= DSEQ - HIST) cs = css + ((size_t)(rr >> 5) * HIST + (t - (DSEQ - HIST))) * D; }
                    if (cs) { *(f32x4*)(cs + ch0) = c0; *(f32x4*)(cs + ch0 + 4) = c1; } }
        } else {
            const int ch0 = (j - 12) * 128 + wc * 32 + 8 * fq;
#pragma unroll
            for (int ai = 0; ai < 2; ++ai)
#pragma unroll
                for (int m = 0; m < 4; ++m) { const int row = row0 + ai * 128 + m * 16; f32x4 r0, r1, s0, s1;
#pragma unroll
                    for (int e = 0; e < 4; ++e) {
                        const float ea0 = __expf(-acc[ai][0][m][0][e]), eb0 = __expf(-acc[ai][1][m][0][e]), ea1 = __expf(-acc[ai][0][m][1][e]), eb1 = __expf(-acc[ai][1][m][1][e]);
                        s0[e] = 1.f / (1.f + eb0); s1[e] = 1.f / (1.f + eb1); r0[e] = (1.f + eb0) / (1.f + ea0); r1[e] = (1.f + eb1) / (1.f + ea1); }
                    *(u32x4*)(RR + (size_t)row * D + ch0) = pack8(r0, r1); *(u32x4*)(SGB + (size_t)row * D + ch0) = pack8(s0, s1); }
        }
    }
};

#define LDS_BARRIER() do { asm volatile("s_waitcnt lgkmcnt(0)" ::: "memory"); __builtin_amdgcn_s_barrier(); asm volatile("" ::: "memory"); } while (0)
__device__ __forceinline__ void sg_epi(const f32x16& acc, const u32x2 (&uu)[4], float bias, bf16* Arow, int h) {
#pragma unroll
    for (int eg = 0; eg < 4; ++eg) { u32x2 o; o.x = pk2(bflo(uu[eg].x) * (acc[4 * eg] + bias), bfhi(uu[eg].x) * (acc[4 * eg + 1] + bias)); o.y = pk2(bflo(uu[eg].y) * (acc[4 * eg + 2] + bias), bfhi(uu[eg].y) * (acc[4 * eg + 3] + bias));
        *(u32x2*)(Arow + 8 * eg + 4 * h) = o; }
}
template <int PAIR>
__device__ __forceinline__ void sg_group_mma(Frame& F, const LAS unsigned char* tile, const bf16* WSG, const bf16* U, bf16* A, int row0, int g) {
    constexpr int tbA = PAIR ? 1 : 0, tbB = PAIR ? 2 : 3, nks = 2 * (tbB + 1), nksA = 2 * (tbA + 1);
    const int lane = F.lane, r = lane & 31, h = lane >> 5, cb = F.wave & 3;
    const bf16* wA = WSG + ((size_t)g * 128 + 32 * tbA + r) * 128 + 8 * h; const bf16* wB = WSG + ((size_t)g * 128 + 32 * tbB + r) * 128 + 8 * h;
    bf16x8 bB[nks], bA[nksA];
#pragma unroll
    for (int ks = 0; ks < nks; ++ks) bB[ks] = *(const bf16x8*)(wB + 16 * ks);
#pragma unroll
    for (int ks = 0; ks < nksA; ++ks) bA[ks] = *(const bf16x8*)(wA + 16 * ks);
    const size_t offA = (size_t)(row0 + 32 * tbA + r) * D + g * 128 + cb * 32, offB = (size_t)(row0 + 32 * tbB + r) * D + g * 128 + cb * 32;
    u32x2 uA[4], uB[4];
#pragma unroll
    for (int eg = 0; eg < 4; ++eg) { uA[eg] = *(const u32x2*)(U + offA + 8 * eg + 4 * h); uB[eg] = *(const u32x2*)(U + offB + 8 * eg + 4 * h); }
    const float biasA = par(F, PO_BSG)[g * 128 + 32 * tbA + r], biasB = par(F, PO_BSG)[g * 128 + 32 * tbB + r];
    f32x16 accA, accB;
#pragma unroll
    for (int e = 0; e < 16; ++e) { accA[e] = 0.f; accB[e] = 0.f; }
    const int arow = cb * 32 + r;
#pragma unroll
    for (int ks = 0; ks < nks; ++ks) {
        const bf16x8 a = *(const LAS bf16x8*)(tile + arow * 256 + (((2 * ks + h) ^ (arow & 15)) << 4));
        accB = __builtin_amdgcn_mfma_f32_32x32x16_bf16(a, bB[ks], accB, 0, 0, 0);
        if (ks < nksA) accA = __builtin_amdgcn_mfma_f32_32x32x16_bf16(a, bA[ks], accA, 0, 0, 0);
    }
    sg_epi(accA, uA, biasA, A + offA, h); sg_epi(accB, uB, biasB, A + offB, h);
}
__device__ __forceinline__ void sg_item128(Frame& F, int row0) {
    LAS float* ST = (LAS float*)(F.lds);
    LAS float* red = (LAS float*)(F.lds + 1024);
    LAS unsigned char* tiles = F.lds + 16384;
    const bf16* VT = slot(F, 2); const bf16* U = slot(F, 1); bf16* A = slot(F, 0); const bf16* WSG = wsb(F, WS_WSG);
    PHASE_IDS(F);
    const int tid = F.tid;
    LDS_BARRIER();
    if (tid < 128) { const float* vp = (const float*)(F.ws + WS_HSS1) + (size_t)(row0 + tid) * 2; float S = 0.f, Q = 0.f;
#pragma unroll
        for (int pt = 0; pt < 8; ++pt) { const f32x2 t = *(const f32x2*)(vp + (size_t)pt * M * 2); S += t.x; Q += t.y; }
        const float mu = S * (1.f / D), var = Q * (1.f / D) - mu * mu; ST[2 * tid] = mu; ST[2 * tid + 1] = 1.f / sqrtf(var + EPS); }
    LDS_BARRIER();
    const int so = tid & 15, c0 = tid >> 4;
    float mu[8], rho[8];
#pragma unroll
    for (int p = 0; p < 4; ++p) { const f32x4 s4 = *(const LAS f32x4*)(ST + 2 * (8 * so) + 4 * p); mu[2 * p] = s4.x; rho[2 * p] = s4.y; mu[2 * p + 1] = s4.z; rho[2 * p + 1] = s4.w; }
    u32x4 raw[4];
    auto issue = [&](int g) {
        const bf16* vt = VT + (size_t)(g * 128) * M + row0; asm volatile("" : "+s"(vt));
#pragma unroll
        for (int i = 0; i < 4; ++i) raw[i] = *(const u32x4*)(vt + (size_t)(c0 + 32 * i) * M + 8 * so); };
    auto stage = [&](int g, LAS unsigned char* tile) {
#pragma unroll
        for (int i = 0; i < 4; ++i) { const int ch = c0 + 32 * i; const float gam = par(F, PO_GSGV)[g * 128 + ch], bet = par(F, PO_BSGV)[g * 128 + ch]; u32x4 w;
#pragma unroll
            for (int p = 0; p < 4; ++p) w[p] = pk2((bflo(raw[i][p]) - mu[2 * p]) * (rho[2 * p] * gam) + bet, (bfhi(raw[i][p]) - mu[2 * p + 1]) * (rho[2 * p + 1] * gam) + bet);
            *(LAS u32x4*)(tile + ch * 256 + ((so ^ (ch & 15)) << 4)) = w; } };
    issue(0); stage(0, tiles);
    LDS_BARRIER();
#pragma clang loop unroll(disable)
    for (int g = 0; g < 8; ++g) {
        LAS unsigned char* cur = tiles + (g & 1) * 32768;
        if (g < 7) issue(g + 1);
        if (F.wave >> 2) sg_group_mma<1>(F, cur, WSG, U, A, row0, g); else sg_group_mma<0>(F, cur, WSG, U, A, row0, g);
        if (g < 7) stage(g + 1, tiles + ((g + 1) & 1) * 32768);
        LDS_BARRIER();
    }
}
__device__ __forceinline__ void sg_tile32(Frame& F, int b, int g, int cb, float* sgv_out) {
    LAS float* ST = (LAS float*)(F.lds);
    const bf16* VT = slot(F, 2); const bf16* U = slot(F, 1); bf16* A = slot(F, 0); const bf16* WSG = wsb(F, WS_WSG);
    PHASE_IDS(F);
    const int lane = F.lane, r = lane & 31, h = lane >> 5, row0 = MP + 32 * b;
    LDS_BARRIER();
    if (F.tid < 32) { const float* vp = (const float*)(F.ws + WS_PAR) + PO_SVST + (size_t)(32 * b + F.tid) * 2; float S = 0.f, Q = 0.f;
#pragma unroll
        for (int pt = 0; pt < 32; ++pt) { const f32x2 t = *(const f32x2*)(vp + (size_t)pt * 512); S += t.x; Q += t.y; }
        const float mu = S * (1.f / D), var = Q * (1.f / D) - mu * mu; ST[2 * F.tid] = mu; ST[2 * F.tid + 1] = 1.f / sqrtf(var + EPS); }
    LDS_BARRIER();
    if (F.wave == 0) {
        const int ch = g * 128 + cb * 32 + r; const float gam = par(F, PO_GSGV)[ch], bet = par(F, PO_BSGV)[ch];
        const bf16* vrow = VT + (size_t)ch * M + row0 + 8 * h; const bf16* wA = WSG + ((size_t)g * 128 + r) * 128 + 8 * h;
        const size_t off = (size_t)(row0 + r) * D + g * 128 + cb * 32; u32x2 uu[4];
#pragma unroll
        for (int eg = 0; eg < 4; ++eg) uu[eg] = *(const u32x2*)(U + off + 8 * eg + 4 * h);
        f32x16 acc;
#pragma unroll
        for (int e = 0; e < 16; ++e) acc[e] = 0.f;
#pragma unroll
        for (int ks = 0; ks < 2; ++ks) {
            const u32x4 v = *(const u32x4*)(vrow + 16 * ks); const LAS f32x4* st = (const LAS f32x4*)(ST + 2 * (16 * ks + 8 * h)); float y[8];
#pragma unroll
            for (int p = 0; p < 4; ++p) { const f32x4 s4 = st[p]; y[2 * p] = (bflo(v[p]) - s4.x) * (s4.y * gam) + bet; y[2 * p + 1] = (bfhi(v[p]) - s4.z) * (s4.w * gam) + bet; }
#pragma unroll
            for (int j = 0; j < 8; ++j) sgv_out[(size_t)(16 * ks + 8 * h + j) * D + ch] = y[j];
            u32x4 w; w.x = pk2(y[0], y[1]); w.y = pk2(y[2], y[3]); w.z = pk2(y[4], y[5]); w.w = pk2(y[6], y[7]);
            const bf16x8 bfr = *(const bf16x8*)(wA + 16 * ks);
            acc = __builtin_amdgcn_mfma_f32_32x32x16_bf16(__builtin_bit_cast(bf16x8, w), bfr, acc, 0, 0, 0); }
        sg_epi(acc, uu, par(F, PO_BSG)[g * 128 + r], A + off, h);
    }
}
template <int NT>
__device__ __forceinline__ void conv_item(Frame& F, int row0, int hist_mode  , const float* cache_b, int t0 = 0) {
    LAS float* wred = (LAS float*)(F.lds + 90112);
    LAS float* ST2 = (LAS float*)(F.lds + 90112 + 1024);
    const bf16* C = slot(F, 3); bf16* BB = slot(F, 6);
    PHASE_IDS(F);
    const int tid = F.tid, lane = F.lane, wave = F.wave, c2 = 2 * tid;
    f32x2 w[CW];
    { const float* wp = par(F, PO_WDW) + c2;
#pragma unroll
      for (int j = 0; j < CW; ++j) { w[j] = *(const GAS f32x2*)wp; wp += D; asm volatile("" : "+v"(wp)); } }
    const f32x2 bd = *(const f32x2*)(par(F, PO_BDW) + c2), gc = *(const f32x2*)(par(F, PO_GCLN) + c2), bc = *(const f32x2*)(par(F, PO_BCLN) + c2);
    LDS_BARRIER();
    f32x2 win[HIST + 8];
#pragma unroll
    for (int i = 0; i < HIST + 8; ++i) win[i] = (f32x2){0.f, 0.f};
    if (hist_mode == 1) {
        const bf16* hp = C + (size_t)(row0 - HIST) * D + c2;
#pragma unroll
        for (int i = 0; i < HIST; ++i) { const unsigned v = *(const unsigned*)hp; win[i] = (f32x2){bflo(v), bfhi(v)}; hp += D; asm volatile("" : "+v"(hp)); }
    } else if (hist_mode == 2) {
        const float* hp = cache_b + c2;
#pragma unroll
        for (int i = 0; i < HIST; ++i) { win[i] = *(const f32x2*)hp; hp += D; asm volatile("" : "+v"(hp)); }
    } else if (hist_mode == 3) {
#pragma unroll
        for (int i = 0; i < HIST; ++i) { const int t = t0 - HIST + i;
            if (t < 0) win[i] = *(const f32x2*)(cache_b + (size_t)(HIST + t) * D + c2);
            else { const unsigned v = *(const unsigned*)(C + (size_t)(row0 - t0 + t) * D + c2); win[i] = (f32x2){bflo(v), bfhi(v)}; } }
    }
    const bf16* cp = C + (size_t)row0 * D + c2; bf16* op = BB + (size_t)row0 * D + c2;
    unsigned rawA[8], rawB[8];
#pragma unroll
    for (int i = 0; i < 8; ++i) { rawA[i] = *(const unsigned*)(cp + (size_t)i * D); rawB[i] = NT > 8 ? *(const unsigned*)(cp + (size_t)(8 + i) * D) : 0u; }
#define CONV_BATCH(RAW, MORE) do { \
        f32x2 dw[8]; float x[16]; \
        _Pragma("unroll") for (int i = 0; i < 8; ++i) { win[HIST + i] = (f32x2){bflo(RAW[i]), bfhi(RAW[i])}; dw[i] = bd; } \
        if (MORE) { _Pragma("unroll") for (int i = 0; i < 8; ++i) RAW[i] = *(const unsigned*)(cp + (size_t)(16 + i) * D); } \
        cp += 8 * D; \
        _Pragma("unroll") for (int j = 0; j < CW; ++j) _Pragma("unroll") for (int i = 0; i < 8; ++i) dw[i] += w[j] * win[i + j]; \
        _Pragma("unroll") for (int i = 0; i < 8; ++i) { x[2 * i] = dw[i].x + dw[i].y; x[2 * i + 1] = dw[i].x * dw[i].x + dw[i].y * dw[i].y; } \
        _Pragma("unroll") for (int i = 0; i < HIST; ++i) win[i] = win[i + 8]; \
          \
        _Pragma("unroll") for (int st = 0; st < 4; ++st) { const int n = 8 >> st, bit = 32 >> st; \
            const unsigned long long upm = st == 0 ? 0xffffffff00000000ull : st == 1 ? 0xffff0000ffff0000ull : st == 2 ? 0xff00ff00ff00ff00ull : 0xf0f0f0f0f0f0f0f0ull; \
            _Pragma("unroll") for (int i = 0; i < n; ++i) { const float keep = lane_sel(upm, x[i], x[i + n]), send = lane_sel(upm, x[i + n], x[i]); x[i] = keep + __shfl_xor(send, bit); } } \
        x[0] += __shfl_xor(x[0], 2); x[0] += __shfl_xor(x[0], 1); \
        LDS_BARRIER(); \
        if ((lane & 3) == 0) wred[wave * 16 + (lane >> 2)] = x[0]; \
        LDS_BARRIER(); \
        if (tid < 16) { float tot = 0.f; \
            _Pragma("unroll") for (int wv = 0; wv < 8; ++wv) tot += wred[wv * 16 + tid]; \
            const float oth = __shfl_xor(tot, 1); \
            if ((tid & 1) == 0) { const float mu = tot * (1.f / D), var = oth * (1.f / D) - mu * mu; ST2[tid] = mu; ST2[tid + 1] = 1.f / sqrtf(var + EPS); } } \
        LDS_BARRIER(); \
        _Pragma("unroll") for (int i = 0; i < 8; ++i) { const f32x2 ms = *(const LAS f32x2*)(ST2 + 2 * i); \
            const float y0 = (dw[i].x - ms.x) * ms.y * gc.x + bc.x, y1 = (dw[i].y - ms.x) * ms.y * gc.y + bc.y; \
            *(unsigned*)(op + (size_t)i * D) = pk2(y0 * sigm(y0), y1 * sigm(y1)); } \
        op += 8 * D; } while (0)
#pragma clang loop unroll(disable)
    for (int base = 0; base < NT; base += 16) { const bool more = base + 16 < NT; CONV_BATCH(rawA, more); if (NT > 8) CONV_BATCH(rawB, more); }
#undef CONV_BATCH
}
__device__ __forceinline__ void p2_branch_a(Frame& F) {
    float* sgv = F.out + (size_t)M * D + 2 * (size_t)DB * HIST * D;
    for (int it = F.vcu; it < MP / 128; it += F.G) sg_item128(F, it * 128);
    for (int it = F.vcu; it < DB * 32; it += F.G) { const int b = it & 7, g = (it >> 3) & 7, cb = it >> 6; sg_tile32(F, b, g, cb, sgv + (size_t)b * DSEQ * D); }
}
__device__ __forceinline__ void p2_branch_b(Frame& F) {
    for (int it = F.vcu; it < MP / 128; it += F.G) conv_item<128>(F, it * 128, (it & 31) ? 1 : 0, nullptr);
    for (int it = F.vcu; it < DB * 4; it += F.G) { const int b = it & 7, q = it >> 3;
        conv_item<8>(F, MP + 32 * b + 8 * q, 3, par(F, PO_CACHE) + (size_t)b * HIST * D, 8 * q); }
}
__device__ __forceinline__ void p2_mixers(Frame& F) {
    if (F.vcu & 1) { p2_branch_b(F); asm volatile("" ::: "memory"); p2_branch_a(F); }
    else { p2_branch_a(F); asm volatile("" ::: "memory"); p2_branch_b(F); }
}
struct SchedStd {
    pg8::StaticOrder so;
    __device__ void init(int nM, int nN, int G, int c) { so.init(nM, nN, G, c); }
    __device__ bool next(int i, pg8::Unit& u) const { return so.next(i, u); }
};
__device__ __forceinline__ void mul8(f32x4& a, f32x4& b, const u32x4 w) {
    a.x *= bflo(w.x); a.y *= bfhi(w.x); a.z *= bflo(w.y); a.w *= bfhi(w.y); b.x *= bflo(w.z); b.y *= bfhi(w.z); b.z *= bflo(w.w); b.w *= bfhi(w.w);
}
struct EpiP3 {
    static constexpr bool PERM = true, HAS_MID = true; static constexpr int TRAIL = 0;
    const bf16 *RR, *SGB; bf16* MIX;
    __device__ __forceinline__ void mid(f32x4 (&acc)[2][2][4][2], const pg8::Unit& u, int wr, int wc, int, int) const {
        const int lane_ = lane_id(), fr = lane_ & 15, fq = lane_ >> 4;
        const int row0 = u.pm * 256 + wr * 64 + fr, col0 = u.pn * 256 + wc * 32 + 8 * fq;
#pragma unroll
        for (int ai = 0; ai < 2; ++ai)
#pragma unroll
            for (int m = 0; m < 4; ++m) { const bf16* rowp = RR + (size_t)(row0 + ai * 128 + m * 16) * D + col0;
#pragma unroll
                for (int bj = 0; bj < 2; ++bj) { const u32x4 w = *(const u32x4*)(rowp + bj * 128); mul8(acc[ai][bj][m][0], acc[ai][bj][m][1], w); }
                if (m & 1) asm volatile("" ::: "memory"); }
    }
    __device__ __forceinline__ void operator()(const f32x4 (&acc)[2][2][4][2], const pg8::Unit& u, int wr, int wc, int, int) const {
        const int lane_ = lane_id(), fr = lane_ & 15, fq = lane_ >> 4;
        const int row0 = u.pm * 256 + wr * 64 + fr, col0 = u.pn * 256 + wc * 32 + 8 * fq;
#pragma unroll
        for (int ai = 0; ai < 2; ++ai)
#pragma unroll
            for (int m = 0; m < 4; ++m) { const size_t off = (size_t)(row0 + ai * 128 + m * 16) * D + col0;
#pragma unroll
                for (int bj = 0; bj < 2; ++bj) { const u32x4 w = *(const u32x4*)(SGB + off + bj * 128); f32x4 a = acc[ai][bj][m][0], b = acc[ai][bj][m][1]; mul8(a, b, w);
                    *(u32x4*)(MIX + off + bj * 128) = pack8(a, b); }
                if (m & 1) asm volatile("" ::: "memory"); }
    }
};
struct EpiP4 {
    static constexpr bool PERM = true, HAS_MID = false; static constexpr int TRAIL = 0;
    const float *xp; bf16* HB; float* HSS;
    __device__ __forceinline__ void mid(f32x4 (&acc)[2][2][4][2], const pg8::Unit& u, int wr, int wc, int, int) const {}
    __device__ __forceinline__ void operator()(const f32x4 (&acc)[2][2][4][2], const pg8::Unit& u, int wr, int wc, int, int) const {
        const int lane_ = lane_id(), fr = lane_ & 15, fq = lane_ >> 4;
        const int row0 = u.pm * 256 + wr * 64 + fr, col0 = u.pn * 256 + wc * 32 + 8 * fq;
#pragma unroll
        for (int ai = 0; ai < 2; ++ai) {
#pragma unroll
            for (int m = 0; m < 4; ++m) { const int row = row0 + ai * 128 + m * 16; const size_t off = (size_t)row * D + col0; const float* xr = xp + off; float ss = 0.f;
#pragma unroll
                for (int bj = 0; bj < 2; ++bj) { const f32x4 h0 = *(const f32x4*)(xr + bj * 128) + acc[ai][bj][m][0], h1 = *(const f32x4*)(xr + bj * 128 + 4) + acc[ai][bj][m][1];
                    *(u32x4*)(HB + off + bj * 128) = pack8(h0, h1);
                    ss += (h0.x * h0.x + h0.y * h0.y) + (h0.z * h0.z + h0.w * h0.w) + (h1.x * h1.x + h1.y * h1.y) + (h1.z * h1.z + h1.w * h1.w); }
                ss += __shfl_xor(ss, 16); ss += __shfl_xor(ss, 32);
                if (fq == 0) HSS[(size_t)row * 16 + u.pn * 4 + wc] = ss; }
            asm volatile("" ::: "memory"); }
    }
};
struct EpiP5 {
    static constexpr bool PERM = true, HAS_MID = false; static constexpr int TRAIL = 16;
    bf16* ACT;
    __device__ __forceinline__ void mid(f32x4 (&acc)[2][2][4][2], const pg8::Unit& u, int wr, int wc, int, int) const {}
    __device__ __forceinline__ void operator()(const f32x4 (&acc)[2][2][4][2], const pg8::Unit& u, int wr, int wc, int, int) const {
        const int lane_ = lane_id(), fr = lane_ & 15, fq = lane_ >> 4;
        const int row0 = u.pm * 256 + wr * 64 + fr, col0 = u.pn * 256 + wc * 32 + 8 * fq;
#pragma unroll
        for (int ai = 0; ai < 2; ++ai)
#pragma unroll
            for (int m = 0; m < 4; ++m) { bf16* rowp = ACT + (size_t)(row0 + ai * 128 + m * 16) * FF + col0;
#pragma unroll
                for (int bj = 0; bj < 2; ++bj) { f32x4 a = acc[ai][bj][m][0], b = acc[ai][bj][m][1];
#pragma unroll
                    for (int e = 0; e < 4; ++e) { const float ra = a[e] > 0.f ? a[e] : 0.f, rb = b[e] > 0.f ? b[e] : 0.f; a[e] = ra * ra; b[e] = rb * rb; }
                    *(u32x4*)(rowp + bj * 128) = pack8(a, b); } }
    }
};
__device__ __forceinline__ float row_ss16(const float* p) {
    const f32x4 a = *(const f32x4*)p, b = *(const f32x4*)(p + 4), c = *(const f32x4*)(p + 8), d = *(const f32x4*)(p + 12);
    return ((a.x + a.y) + (a.z + a.w)) + ((b.x + b.y) + (b.z + b.w)) + ((c.x + c.y) + (c.z + c.w)) + ((d.x + d.y) + (d.z + d.w));
}
struct EpiP6 {
    static constexpr bool PERM = true, HAS_MID = false; static constexpr int TRAIL = 0;
    const bf16* H1; bf16* H2; const float* HSS1; float* HSS2;
    __device__ __forceinline__ void mid(f32x4 (&acc)[2][2][4][2], const pg8::Unit& u, int wr, int wc, int, int) const {}
    __device__ __forceinline__ void operator()(const f32x4 (&acc)[2][2][4][2], const pg8::Unit& u, int wr, int wc, int, int) const {
        const int lane_ = lane_id(), fr = lane_ & 15, fq = lane_ >> 4;
        const int row0 = u.pm * 256 + wr * 64 + fr, col0 = u.pn * 256 + wc * 32 + 8 * fq;
#pragma unroll
        for (int ai = 0; ai < 2; ++ai) {
#pragma unroll
            for (int m = 0; m < 4; ++m) { const int row = row0 + ai * 128 + m * 16; const size_t off = (size_t)row * D + col0; float ss = 0.f;
                const float rinv = 1.f / (row_ss16(HSS1 + (size_t)row * 16) * (1.f / D) + EPS);
#pragma unroll
                for (int bj = 0; bj < 2; ++bj) { const u32x4 w = *(const u32x4*)(H1 + off + bj * 128);
                    f32x4 h0 = acc[ai][bj][m][0] * rinv, h1 = acc[ai][bj][m][1] * rinv;
                    h0.x += bflo(w.x); h0.y += bfhi(w.x); h0.z += bflo(w.y); h0.w += bfhi(w.y); h1.x += bflo(w.z); h1.y += bfhi(w.z); h1.z += bflo(w.w); h1.w += bfhi(w.w);
                    *(u32x4*)(H2 + off + bj * 128) = pack8(h0, h1);
                    ss += (h0.x * h0.x + h0.y * h0.y) + (h0.z * h0.z + h0.w * h0.w) + (h1.x * h1.x + h1.y * h1.y) + (h1.z * h1.z + h1.w * h1.w); }
                ss += __shfl_xor(ss, 16); ss += __shfl_xor(ss, 32);
                if (fq == 0) HSS2[(size_t)row * 16 + u.pn * 4 + wc] = ss; }
            asm volatile("" ::: "memory"); }
    }
};
struct EpiP7 {
    static constexpr bool PERM = true, HAS_MID = true; static constexpr int TRAIL = 0;
    bf16* H3; bf16* PE; const float* HSS2; const bf16* H2;
    __device__ __forceinline__ void mid(f32x4 (&acc)[2][2][4][2], const pg8::Unit& u, int wr, int wc, int, int) const {
        const int lane_ = lane_id(), fr = lane_ & 15, fq = lane_ >> 4;
        const int row0 = u.pm * 256 + wr * 64 + fr, col0 = u.pn * 256 + wc * 32 + 8 * fq;
#pragma unroll
        for (int ai = 0; ai < 2; ++ai)
#pragma unroll
            for (int m = 0; m < 4; ++m) { bf16* rowp = PE + (size_t)(row0 + ai * 128 + m * 16) * D + col0;
#pragma unroll
                for (int bj = 0; bj < 2; ++bj) { *(u32x4*)(rowp + bj * 128) = pack8(acc[ai][bj][m][0], acc[ai][bj][m][1]); acc[ai][bj][m][0] = (f32x4){0.f, 0.f, 0.f, 0.f}; acc[ai][bj][m][1] = (f32x4){0.f, 0.f, 0.f, 0.f}; } }
    }
    __device__ __forceinline__ void operator()(const f32x4 (&acc)[2][2][4][2], const pg8::Unit& u, int wr, int wc, int, int) const {
        const int lane_ = lane_id(), fr = lane_ & 15, fq = lane_ >> 4;
        const int row0 = u.pm * 256 + wr * 64 + fr, col0 = u.pn * 256 + wc * 32 + 8 * fq;
#pragma unroll
        for (int ai = 0; ai < 2; ++ai) {
#pragma unroll
            for (int m = 0; m < 4; ++m) { const int row = row0 + ai * 128 + m * 16; const size_t off = (size_t)row * D + col0;
                const float rs = 1.f / sqrtf(row_ss16(HSS2 + (size_t)row * 16) * (1.f / D) + EPS);
#pragma unroll
                for (int bj = 0; bj < 2; ++bj) { const u32x4 w = *(const u32x4*)(PE + off + bj * 128), hw = *(const u32x4*)(H2 + off + bj * 128); f32x4 g0, g1;
#pragma unroll
                    for (int e = 0; e < 4; ++e) { g0[e] = sigm(rs * acc[ai][bj][m][0][e]); g1[e] = sigm(rs * acc[ai][bj][m][1][e]); }
                    mul8(g0, g1, w);
                    g0.x += bflo(hw.x); g0.y += bfhi(hw.x); g0.z += bflo(hw.y); g0.w += bfhi(hw.y); g1.x += bflo(hw.z); g1.y += bfhi(hw.z); g1.z += bflo(hw.w); g1.w += bfhi(hw.w);
                    *(u32x4*)(H3 + off + bj * 128) = pack8(g0, g1); } }
            asm volatile("" ::: "memory"); }
    }
};
constexpr int PO_SS1 = PO_END, PO_SS2 = PO_END + 256 * 32;
static_assert(PO_SVST == PO_SS2 + 256 * 32 && (size_t)(PO_SVST + 32 * 512) * 4 <= WS_END - WS_PAR, "PAR region");
template <int NSEG, class Epi>
__device__ __forceinline__ void skinny_tile(Frame& F, const bf16* A0, int lda0, const bf16* B0, int ldb0, int K0, const bf16* A1, int lda1, const bf16* B1, int ldb1, int K1, const Epi& epi) {
    LAS float* red = (LAS float*)F.lds;
    const int lane = F.lane, wave = F.wave, r = lane & 31, h = lane >> 5;
    f32x16 acc0, acc1;
#pragma unroll
    for (int e = 0; e < 16; ++e) { acc0[e] = 0.f; acc1[e] = 0.f; }
    { const int kw = K0 >> 3; const bf16* ap = A0 + (size_t)r * lda0 + wave * kw + 8 * h; const bf16* bp = B0 + (size_t)r * ldb0 + wave * kw + 8 * h;
#pragma unroll 4
      for (int k = 0; k < kw; k += 16) { const bf16x8 a = *(const bf16x8*)(ap + k), b = *(const bf16x8*)(bp + k); acc0 = __builtin_amdgcn_mfma_f32_32x32x16_bf16(a, b, acc0, 0, 0, 0); } }
    if constexpr (NSEG == 2) { const int kw = K1 >> 3; const bf16* ap = A1 + (size_t)r * lda1 + wave * kw + 8 * h; const bf16* bp = B1 + (size_t)r * ldb1 + wave * kw + 8 * h;
#pragma unroll 4
      for (int k = 0; k < kw; k += 16) { const bf16x8 a = *(const bf16x8*)(ap + k), b = *(const bf16x8*)(bp + k); acc1 = __builtin_amdgcn_mfma_f32_32x32x16_bf16(a, b, acc1, 0, 0, 0); } }
#pragma unroll
    for (int e = 0; e < 16; ++e) { const int row = (e & 3) + 8 * (e >> 2) + 4 * h; red[(wave * NSEG) * 1024 + row * 32 + r] = acc0[e]; if constexpr (NSEG == 2) red[(wave * NSEG + 1) * 1024 + row * 32 + r] = acc1[e]; }
    __syncthreads();
    const int row = F.tid >> 4, c0 = 2 * (F.tid & 15);
    float p[2] = {0.f, 0.f}, q[2] = {0.f, 0.f};
#pragma unroll
    for (int w = 0; w < 8; ++w) { const f32x2 t = *(const LAS f32x2*)(red + (w * NSEG) * 1024 + row * 32 + c0); p[0] += t.x; p[1] += t.y;
        if constexpr (NSEG == 2) { const f32x2 t2 = *(const LAS f32x2*)(red + (w * NSEG + 1) * 1024 + row * 32 + c0); q[0] += t2.x; q[1] += t2.y; } }
    epi(row, c0, p, q);
    __syncthreads();
}
__device__ __forceinline__ float sum16(float v) { v += __shfl_xor(v, 1); v += __shfl_xor(v, 2); v += __shfl_xor(v, 4); v += __shfl_xor(v, 8); return v; }
__device__ __forceinline__ float ss_row32(const float* p) { float s = 0.f;
#pragma unroll
    for (int i = 0; i < 32; ++i) s += p[i * 256]; return s; }
__device__ __forceinline__ void s1_sample(Frame& F) {
    const bf16* XN = slot(F, 0); const bf16* WR = wsb(F, WS_WR); const bf16* WV = wsb(F, WS_WV);
    bf16 *U = slot(F, 1), *VT = slot(F, 2), *C = slot(F, 3), *RR = slot(F, 4), *SGB = slot(F, 5); float* css = F.out + (size_t)M * D + (size_t)DB * HIST * D;
    for (int u = F.vcu; u < 8 * 128; u += F.G) {
        const int rb = u & 7, blk = u >> 3, type = blk >> 5, jb = blk & 31, row0 = MP + 32 * rb; const bf16* A = XN + (size_t)row0 * D;
        if (type == 0) skinny_tile<1>(F, A, D, WR + (size_t)(32 * jb) * D, D, D, A, D, WR, D, D, [&](int row, int c0, const float* p, const float*) {
            *(unsigned*)(U + (size_t)(row0 + row) * D + 32 * jb + c0) = pk2(p[0], p[1]); });
        else if (type == 1) skinny_tile<1>(F, A, D, WV + (size_t)(32 * jb) * D, D, D, A, D, WV, D, D, [&](int row, int c0, const float* p, const float*) {
            VT[(size_t)(32 * jb + c0) * M + row0 + row] = (bf16)f2bf(p[0]); VT[(size_t)(32 * jb + c0 + 1) * M + row0 + row] = (bf16)f2bf(p[1]);
            const float ps = sum16(p[0] + p[1]), pq = sum16(p[0] * p[0] + p[1] * p[1]);
            if ((F.tid & 15) == 0) *(f32x2*)((float*)(F.ws + WS_PAR) + PO_SVST + ((size_t)jb * 256 + 32 * rb + row) * 2) = (f32x2){ps, pq}; });
        else { const int wrow = (type == 2 ? 1024 : 3072) + 256 * (jb >> 2) + 32 * (jb & 3);
            const bf16* Ba = WR + (size_t)wrow * D; const bf16* Bb = Ba + (size_t)128 * D;
            if (type == 2) skinny_tile<2>(F, A, D, Ba, D, D, A, D, Bb, D, D, [&](int row, int c0, const float* p, const float* q) {
                const float v0 = p[0] * sigm(q[0]), v1 = p[1] * sigm(q[1]); const int t = row;
                *(unsigned*)(C + (size_t)(row0 + row) * D + 32 * jb + c0) = pk2(v0, v1);
                if (t >= DSEQ - HIST) *(f32x2*)(css + ((size_t)rb * HIST + (t - (DSEQ - HIST))) * D + 32 * jb + c0) = (f32x2){v0, v1}; });
            else skinny_tile<2>(F, A, D, Ba, D, D, A, D, Bb, D, D, [&](int row, int c0, const float* p, const float* q) {
                const float ea0 = __expf(-p[0]), ea1 = __expf(-p[1]), eb0 = __expf(-q[0]), eb1 = __expf(-q[1]); const size_t off = (size_t)(row0 + row) * D + 32 * jb + c0;
                *(unsigned*)(RR + off) = pk2((1.f + eb0) / (1.f + ea0), (1.f + eb1) / (1.f + ea1)); *(unsigned*)(SGB + off) = pk2(1.f / (1.f + eb0), 1.f / (1.f + eb1)); }); }
    }
}
__device__ __forceinline__ void s3_sample(Frame& F) {
    const bf16 *A = slot(F, 0), *BB = slot(F, 6), *RR = slot(F, 4), *SGB = slot(F, 5); bf16* MIX = slot(F, 1);
    for (int u = F.vcu; u < 8 * 32; u += F.G) { const int rb = u & 7, jb = u >> 3, row0 = MP + 32 * rb;
        skinny_tile<2>(F, A + (size_t)row0 * D, D, wsb(F, WS_WA) + (size_t)(32 * jb) * D, D, D, BB + (size_t)row0 * D, D, wsb(F, WS_WB) + (size_t)(32 * jb) * D, D, D, [&](int row, int c0, const float* p, const float* q) {
            const size_t off = (size_t)(row0 + row) * D + 32 * jb + c0; const unsigned rr = *(const unsigned*)(RR + off), sg = *(const unsigned*)(SGB + off);
            *(unsigned*)(MIX + off) = pk2(bflo(sg) * (bflo(rr) * p[0] + q[0]), bfhi(sg) * (bfhi(rr) * p[1] + q[1])); }); }
}
__device__ __forceinline__ void s4_sample(Frame& F, const float* xs) {
    const bf16* MIX = slot(F, 1); bf16* HB = slot(F, 2); float* SS1 = (float*)(F.ws + WS_PAR) + PO_SS1;
    for (int u = F.vcu; u < 8 * 32; u += F.G) { const int rb = u & 7, jb = u >> 3, row0 = MP + 32 * rb;
        skinny_tile<1>(F, MIX + (size_t)row0 * D, D, wsb(F, WS_WO) + (size_t)(32 * jb) * D, D, D, MIX, D, MIX, D, D, [&](int row, int c0, const float* p, const float*) {
            const size_t off = (size_t)(row0 + row) * D + 32 * jb + c0; const f32x2 x = *(const f32x2*)(xs + (size_t)(32 * rb + row) * D + 32 * jb + c0);
            const float h0 = x.x + p[0], h1 = x.y + p[1]; *(unsigned*)(HB + off) = pk2(h0, h1);
            const float ss = sum16(h0 * h0 + h1 * h1); if ((F.tid & 15) == 0) SS1[jb * 256 + 32 * rb + row] = ss; }); }
}
__device__ __forceinline__ void s5_sample(Frame& F) {
    const bf16* HB = slot(F, 2); bf16* ACT = slot(F, 3);
    for (int u = F.vcu; u < 8 * 128; u += F.G) { const int rb = u & 7, jb = u >> 3, row0 = MP + 32 * rb;
        skinny_tile<1>(F, HB + (size_t)row0 * D, D, wsb(F, WS_WUP) + (size_t)(32 * jb) * D, D, D, HB, D, HB, D, D, [&](int row, int c0, const float* p, const float*) {
            const float a = p[0] > 0.f ? p[0] : 0.f, b = p[1] > 0.f ? p[1] : 0.f; *(unsigned*)(ACT + (size_t)(row0 + row) * FF + 32 * jb + c0) = pk2(a * a, b * b); }); }
}
__device__ __forceinline__ void s6_sample(Frame& F) {
    const bf16* ACT = slot(F, 3); const bf16* HB1 = slot(F, 2); bf16* HB2 = slot(F, 0); const float* SS1 = (const float*)(F.ws + WS_PAR) + PO_SS1; float* SS2 = (float*)(F.ws + WS_PAR) + PO_SS2;
    for (int u = F.vcu; u < 8 * 32; u += F.G) { const int rb = u & 7, jb = u >> 3, row0 = MP + 32 * rb;
        skinny_tile<1>(F, ACT + (size_t)row0 * FF, FF, wsb(F, WS_WDN) + (size_t)(32 * jb) * FF, FF, FF, ACT, FF, ACT, FF, FF, [&](int row, int c0, const float* p, const float*) {
            const size_t off = (size_t)(row0 + row) * D + 32 * jb + c0; const float rinv = 1.f / (ss_row32(SS1 + 32 * rb + row) * (1.f / D) + EPS);
            const unsigned hh = *(const unsigned*)(HB1 + off); const float h0 = bflo(hh) + rinv * p[0], h1 = bfhi(hh) + rinv * p[1];
            *(unsigned*)(HB2 + off) = pk2(h0, h1);
            const float ss = sum16(h0 * h0 + h1 * h1); if ((F.tid & 15) == 0) SS2[jb * 256 + 32 * rb + row] = ss; }); }
}
__device__ __forceinline__ void s7_sample(Frame& F) {
    const bf16* HB2 = slot(F, 0); bf16* H3 = slot(F, 2); const bf16* PB = wsb(F, WS_PB); const float* SS2 = (const float*)(F.ws + WS_PAR) + PO_SS2;
    for (int u = F.vcu; u < 8 * 32; u += F.G) { const int rb = u & 7, jb = u >> 3, row0 = MP + 32 * rb;
        skinny_tile<2>(F, PB + (size_t)row0 * PLE, PLE, wsb(F, WS_WPL) + (size_t)(32 * jb) * PLE, PLE, PLE, HB2 + (size_t)row0 * D, D, wsb(F, WS_WPG) + (size_t)(32 * jb) * D, D, D, [&](int row, int c0, const float* p, const float* q) {
            const size_t off = (size_t)(row0 + row) * D + 32 * jb + c0; const float rs = 1.f / sqrtf(ss_row32(SS2 + 32 * rb + row) * (1.f / D) + EPS);
            const unsigned hh = *(const unsigned*)(HB2 + off); *(unsigned*)(H3 + off) = pk2(bflo(hh) + sigm(rs * q[0]) * p[0], bfhi(hh) + sigm(rs * q[1]) * p[1]); }); }
}
__device__ __forceinline__ void p8_final(Frame& F) {
    const int gw = F.vcu * NWAVES + F.wave, NGW = F.G * NWAVES, lane = F.lane; const bf16* H3 = slot(F, 2);
    f32x4 gf[4];
#pragma unroll
    for (int j = 0; j < 4; ++j) gf[j] = *(const f32x4*)(par(F, PO_GFIN) + 16 * lane + 4 * j);
    for (int m0 = gw; m0 < M; m0 += 4 * NGW) {
        u32x4 a[4], b[4];
#pragma unroll
        for (int q = 0; q < 4; ++q) { const int m = m0 + q * NGW < M ? m0 + q * NGW : m0; a[q] = *(const u32x4*)(H3 + (size_t)m * D + 16 * lane); b[q] = *(const u32x4*)(H3 + (size_t)m * D + 16 * lane + 8); }
#pragma unroll
        for (int q = 0; q < 4; ++q) { const int m = m0 + q * NGW;
            f32x4 v[4]; v[0] = (f32x4){bflo(a[q].x), bfhi(a[q].x), bflo(a[q].y), bfhi(a[q].y)}; v[1] = (f32x4){bflo(a[q].z), bfhi(a[q].z), bflo(a[q].w), bfhi(a[q].w)};
            v[2] = (f32x4){bflo(b[q].x), bfhi(b[q].x), bflo(b[q].y), bfhi(b[q].y)}; v[3] = (f32x4){bflo(b[q].z), bfhi(b[q].z), bflo(b[q].w), bfhi(b[q].w)}; float s = 0.f;
#pragma unroll
            for (int j = 0; j < 4; ++j) s += (v[j].x * v[j].x + v[j].y * v[j].y) + (v[j].z * v[j].z + v[j].w * v[j].w);
            const float rs = 1.f / sqrtf(wave_sum(s) * (1.f / D) + EPS);
            if (m < M) { float* xr = F.out + (size_t)m * D + 16 * lane;
#pragma unroll
                for (int j = 0; j < 4; ++j) *(f32x4*)(xr + 4 * j) = v[j] * rs * gf[j]; } }
    }
}

constexpr int N_PHASES = 9;
__global__ void __launch_bounds__(NTHR, 2) mega_fwd(Args args) {
    extern __shared__ __attribute__((aligned(16))) unsigned char lds[];
    Frame F;
    F.lds = (LAS unsigned char*)lds;
    F.wave = __builtin_amdgcn_readfirstlane((int)threadIdx.x >> 6); PHASE_IDS(F);
    F.G = gridDim.x; { const int bx = blockIdx.x; F.vcu = (F.G % 8 == 0) ? (bx % 8) * (F.G / 8) + bx / 8 : bx; }
    F.out = args.out; F.ws = args.ws;
    volatile LAS unsigned* MISC = (volatile LAS unsigned*)(F.lds + MISC_OFF);
    for (int u = F.tid; u < (LDS_BYTES - LDSCTL_OFF) / 4; u += NTHR) ((LAS unsigned*)(F.lds + LDSCTL_OFF))[u] = 0u;
    __syncthreads();
    const int lo = args.ph_lo, hi = args.ph_hi;
    XcdBarrier bar; bar.bar = (unsigned*)(F.ws + WS_CTL) + CW_BAR; bar.x = 0; bar.st = nullptr;
    if (hi - lo > 1) bar = xcd_barrier_post((unsigned*)(F.ws + WS_CTL) + CW_BAR, MISC + 8, F.wave == 0 && F.lane == 0);
#ifndef PHASE_MASK
#define PHASE_MASK 0x1ff
#endif
#define IN(k) (((PHASE_MASK >> (k)) & 1) && lo <= (k) && (k) < hi)
#ifndef REPEAT_MASK
#define REPEAT_MASK 0
#endif
#define REP(k) for (int rep_ = 0; rep_ < 1 + ((REPEAT_MASK >> (k)) & 1); ++rep_)
#define SEAM(k) do { if (IN(k) && IN((k) + 1)) xcd_barrier(bar, F.wave == 0 && lane_id() == 0); } while (0)
    float* csp = F.out + (size_t)M * D; float* css = csp + (size_t)DB * HIST * D;
    float* HSS1 = (float*)(F.ws + WS_HSS1); float* HSS2 = (float*)(F.ws + WS_HSS2);
    const char* wbase = (const char*)(F.ws + WS_WR);

    if (IN(0)) { REP(0) { PHASE_IDS(F); p0_prologue(F, args); } SEAM(0); }
    if (IN(1)) { REP(1) {
        pg8::Gemm g{wbase, wbase, wbase, wbase, D, D, D, D, 16, 16}; SchedP1 S; S.init(F.G, (int)blockIdx.x);
        EpiP1 E{slot(F, 1), slot(F, 2), slot(F, 3), slot(F, 4), slot(F, 5), csp, css, HSS1  };
        if (F.vcu & 1) { PHASE_IDS(F); s1_sample(F); }
        PHASE_IDS(F); pg8::gemm_phase<EpiP1, SchedP1>(F.lds + RING_OFF, g, S, E, F.tid);
        if (!(F.vcu & 1)) { PHASE_IDS(F); s1_sample(F); }
        }
        SEAM(1);
    }
    if (IN(2)) { REP(2) { PHASE_IDS(F); p2_mixers(F); } SEAM(2); }
    if (IN(3)) { REP(3) {
        pg8::Gemm g{(const char*)slot(F, 0), (const char*)slot(F, 6), (const char*)(F.ws + WS_WA), (const char*)(F.ws + WS_WB), D, D, D, D, 32, 16}; SchedStd S; S.init(MP / 256, 4, F.G, (int)blockIdx.x);
        EpiP3 E{slot(F, 4), slot(F, 5), slot(F, 1)};
        if (F.vcu & 1) { PHASE_IDS(F); s3_sample(F); }
        PHASE_IDS(F); pg8::gemm_phase<EpiP3, SchedStd>(F.lds + RING_OFF, g, S, E, F.tid);
        if (!(F.vcu & 1)) { PHASE_IDS(F); s3_sample(F); }
        }
        SEAM(3);
    }
    if (IN(4)) { REP(4) {
        const char* a = (const char*)slot(F, 1); const char* b = (const char*)(F.ws + WS_WO);
        pg8::Gemm g{a, a, b, b, D, D, D, D, 16, 16}; SchedStd S; S.init(MP / 256, 4, F.G, (int)blockIdx.x);
        EpiP4 E{args.in[0], slot(F, 2), HSS1};
        if (F.vcu & 1) { PHASE_IDS(F); s4_sample(F, args.in[1]); }
        PHASE_IDS(F); pg8::gemm_phase<EpiP4, SchedStd>(F.lds + RING_OFF, g, S, E, F.tid);
        if (!(F.vcu & 1)) { PHASE_IDS(F); s4_sample(F, args.in[1]); }
        }
        SEAM(4);
    }
    if (IN(5)) { REP(5) {
        const char* a = (const char*)slot(F, 2); const char* b = (const char*)(F.ws + WS_WUP);
        pg8::Gemm g{a, a, b, b, D, D, D, D, 16, 16}; SchedStd S; S.init(MP / 256, FF / 256, F.G, (int)blockIdx.x);
        EpiP5 E{slot(F, 3)};
        if (F.vcu & 1) { PHASE_IDS(F); s5_sample(F); }
        PHASE_IDS(F); pg8::gemm_phase<EpiP5, SchedStd>(F.lds + RING_OFF, g, S, E, F.tid);
        if (!(F.vcu & 1)) { PHASE_IDS(F); s5_sample(F); }
        }
        SEAM(5);
    }
    if (IN(6)) { REP(6) {
        const char* a = (const char*)slot(F, 3); const char* b = (const char*)(F.ws + WS_WDN);
        pg8::Gemm g{a, a, b, b, FF, FF, FF, FF, 64, 64}; SchedStd S; S.init(MP / 256, 4, F.G, (int)blockIdx.x);
        EpiP6 E{slot(F, 2), slot(F, 0), HSS1, HSS2};
        if (F.vcu & 1) { PHASE_IDS(F); s6_sample(F); }
        PHASE_IDS(F); pg8::gemm_phase<EpiP6, SchedStd>(F.lds + RING_OFF, g, S, E, F.tid);
        if (!(F.vcu & 1)) { PHASE_IDS(F); s6_sample(F); }
        }
        SEAM(6);
    }
    if (IN(7)) { REP(7) {
        pg8::Gemm g{(const char*)(F.ws + WS_PB), (const char*)slot(F, 0), (const char*)(F.ws + WS_WPL), (const char*)(F.ws + WS_WPG), PLE, D, PLE, D, 20, 4}; SchedStd S; S.init(MP / 256, 4, F.G, (int)blockIdx.x);
        EpiP7 E{slot(F, 2), slot(F, 1), HSS2, slot(F, 0)};
        if (F.vcu & 1) { PHASE_IDS(F); s7_sample(F); }
        PHASE_IDS(F); pg8::gemm_phase<EpiP7, SchedStd, true>(F.lds + RING_OFF, g, S, E, F.tid);
        if (!(F.vcu & 1)) { PHASE_IDS(F); s7_sample(F); }
        }
        SEAM(7);
    }
    if (IN(8)) { REP(8) { PHASE_IDS(F); p8_final(F); } }
#undef IN
#undef SEAM
}
#ifndef MEGA_HI
#define MEGA_HI 9
#endif
#ifndef ONE_LAUNCH
#define ONE_LAUNCH 1
#endif
#if MEGA_HI < 9
__device__ __forceinline__ float block_sum256(float v, float* sh) {
    for (int o = 1; o < 64; o <<= 1) v += __shfl_xor(v, o);
    __syncthreads(); if ((threadIdx.x & 63) == 0) sh[threadIdx.x >> 6] = v; __syncthreads();
    return sh[0] + sh[1] + sh[2] + sh[3];
}
__global__ void k_rms(const float* __restrict__ X, bf16* __restrict__ O) {
    __shared__ float sh[4];
    const int row = blockIdx.x; const float* x = X + (size_t)row * D; float v[4]; float s = 0.f;
    for (int i = 0; i < 4; ++i) { v[i] = x[threadIdx.x + 256 * i]; s += v[i] * v[i]; }
    s = block_sum256(s, sh); const float rs = 1.f / sqrtf(s / D + EPS);
    for (int i = 0; i < 4; ++i) O[(size_t)row * D + threadIdx.x + 256 * i] = (bf16)f2bf(v[i] * rs);
}
__global__ void k_final(float* __restrict__ H, const float* __restrict__ g) {
    __shared__ float sh[4];
    float* x = H + (size_t)blockIdx.x * D; float v[4]; float s = 0.f;
    for (int i = 0; i < 4; ++i) { v[i] = x[threadIdx.x + 256 * i]; s += v[i] * v[i]; }
    s = block_sum256(s, sh); const float rs = 1.f / sqrtf(s / D + EPS);
    for (int i = 0; i < 4; ++i) x[threadIdx.x + 256 * i] = v[i] * rs * g[threadIdx.x + 256 * i];
}
template <class Epi>
__global__ void __launch_bounds__(256) k_gemm(const bf16* __restrict__ A, int lda, const bf16* __restrict__ Bt, int ldb, int K, Epi epi) {
    const int wave = threadIdx.x >> 6, lane = threadIdx.x & 63, r = lane & 31, h = lane >> 5;
    const int row0 = blockIdx.y * 128 + (wave >> 1) * 64, col0 = blockIdx.x * 128 + (wave & 1) * 64;
    f32x16 acc[2][2];
    for (int i = 0; i < 2; ++i) for (int j = 0; j < 2; ++j) for (int e = 0; e < 16; ++e) acc[i][j][e] = 0.f;
    const bf16* ap = A + (size_t)(row0 + r) * lda + 8 * h; const bf16* bp = Bt + (size_t)(col0 + r) * ldb + 8 * h;
    for (int k0 = 0; k0 < K; k0 += 16) {
        bf16x8 a[2], b[2];
        for (int i = 0; i < 2; ++i) { a[i] = *(const bf16x8*)(ap + (size_t)32 * i * lda + k0); b[i] = *(const bf16x8*)(bp + (size_t)32 * i * ldb + k0); }
        for (int i = 0; i < 2; ++i) for (int j = 0; j < 2; ++j) acc[i][j] = __builtin_amdgcn_mfma_f32_32x32x16_bf16(a[i], b[j], acc[i][j], 0, 0, 0);
    }
    for (int i = 0; i < 2; ++i) for (int j = 0; j < 2; ++j) for (int e = 0; e < 16; ++e)
        epi(row0 + 32 * i + (e & 3) + 8 * (e >> 2) + 4 * h, col0 + 32 * j + r, acc[i][j][e]);
}
struct E3a { const bf16* RR; bf16* T; __device__ void operator()(int row, int col, float v) const { size_t i = (size_t)row * D + col; T[i] = (bf16)f2bf(bf2f(RR[i]) * v); } };
struct E3b { const bf16* SGB; const bf16* T; bf16* MIX; __device__ void operator()(int row, int col, float v) const { size_t i = (size_t)row * D + col; MIX[i] = (bf16)f2bf(bf2f(SGB[i]) * (bf2f(T[i]) + v)); } };
struct E4 { const float* xa; const float* xb; float* H; __device__ void operator()(int row, int col, float v) const {
    const float x = row < MP ? xa[(size_t)row * D + col] : xb[(size_t)(row - MP) * D + col]; H[(size_t)row * D + col] = x + v; } };
struct E5 { bf16* ACT; __device__ void operator()(int row, int col, float v) const { const float r = v > 0.f ? v : 0.f; ACT[(size_t)row * FF + col] = (bf16)f2bf(r * r); } };
struct E6 { float* H; __device__ void operator()(int row, int col, float v) const { H[(size_t)row * D + col] += v; } };
struct E7a { bf16* PE; __device__ void operator()(int row, int col, float v) const { PE[(size_t)row * D + col] = (bf16)f2bf(v); } };
struct E7b { const bf16* PE; float* H; __device__ void operator()(int row, int col, float v) const { size_t i = (size_t)row * D + col; H[i] += sigm(v) * bf2f(PE[i]); } };
#endif

extern "C" void kernel_launch(void* const* d_in, const int* in_sizes, int n_in, void* d_out, int out_size, void* d_ws, size_t ws_size, hipStream_t stream) {
    static int grid = 0;
    if (grid == 0) {
        if (n_in != 25 || in_sizes[0] != MP * D || out_size != M * D + 2 * DB * HIST * D + MS * D || ws_size < WS_END) {
            fprintf(stderr, "kernel_launch: unexpected shapes: n_in %d, in0 %d, out %d, ws %zu (need %zu); nothing launched\n", n_in, n_in > 0 ? in_sizes[0] : -1, out_size, ws_size, (size_t)WS_END); grid = -1; return; }
        int dev = 0, cus = 0, per_cu = 0;
        if (hipGetDevice(&dev) != hipSuccess || hipDeviceGetAttribute(&cus, hipDeviceAttributeMultiprocessorCount, dev) != hipSuccess) { fprintf(stderr, "kernel_launch: device query failed\n"); grid = -1; return; }
        if (hipFuncSetAttribute((const void*)mega_fwd, hipFuncAttributeMaxDynamicSharedMemorySize, LDS_BYTES) != hipSuccess) { fprintf(stderr, "kernel_launch: hipFuncSetAttribute failed\n"); grid = -1; return; }
        if (hipOccupancyMaxActiveBlocksPerMultiprocessor(&per_cu, (const void*)mega_fwd, NTHR, LDS_BYTES) != hipSuccess || per_cu < 1)
            fprintf(stderr, "kernel_launch: note: occupancy query reports %d workgroups per CU\n", per_cu);
        (void)hipGetLastError();
        grid = cus;
    }
    if (grid < 0) return;
    if (hipMemsetAsync((char*)d_ws + WS_CTL, 0, CTL_ZERO_BYTES, stream) != hipSuccess) { fprintf(stderr, "kernel_launch: memset failed\n"); return; }
    Args a{};
    for (int i = 0; i < 25; ++i) a.in[i] = (const float*)d_in[i];
    a.out = (float*)d_out; a.ws = (unsigned char*)d_ws;
#if ONE_LAUNCH
    a.ph_lo = 0; a.ph_hi = MEGA_HI;
    hipLaunchKernelGGL(mega_fwd, dim3(grid), dim3(NTHR), LDS_BYTES, stream, a);
#else
    for (int ph = 0; ph < MEGA_HI; ++ph) { a.ph_lo = ph; a.ph_hi = ph + 1; hipLaunchKernelGGL(mega_fwd, dim3(grid), dim3(NTHR), LDS_BYTES, stream, a); }
#endif
    { const hipError_t le = hipPeekAtLastError(); if (le != hipSuccess) fprintf(stderr, "kernel_launch: launch failed: %s\n", hipGetErrorName(le)); }
#if MEGA_HI < 9
    char* ws = (char*)d_ws; float* H = (float*)d_out;
    auto S = [&](int i) { return (bf16*)(ws + WS_S0 + (size_t)i * SLOT); };
    const float* x_p = (const float*)d_in[0]; const float* x_s = (const float*)d_in[1];
    if (MEGA_HI <= 3) {
        k_gemm<E3a><<<dim3(D / 128, M / 128), 256, 0, stream>>>(S(0), D, (const bf16*)(ws + WS_WA), D, D, E3a{S(4), S(2)});
        k_gemm<E3b><<<dim3(D / 128, M / 128), 256, 0, stream>>>(S(6), D, (const bf16*)(ws + WS_WB), D, D, E3b{S(5), S(2), S(1)});
    }
    if (MEGA_HI <= 4) k_gemm<E4><<<dim3(D / 128, M / 128), 256, 0, stream>>>(S(1), D, (const bf16*)(ws + WS_WO), D, D, E4{x_p, x_s, H});
    if (MEGA_HI <= 5) {
        k_rms<<<M, 256, 0, stream>>>(H, S(2));
        k_gemm<E5><<<dim3(FF / 128, M / 128), 256, 0, stream>>>(S(2), D, (const bf16*)(ws + WS_WUP), D, D, E5{S(3)});
        k_gemm<E6><<<dim3(D / 128, M / 128), 256, 0, stream>>>(S(3), FF, (const bf16*)(ws + WS_WDN), FF, FF, E6{H});
    }
    if (MEGA_HI <= 7) {
        k_rms<<<M, 256, 0, stream>>>(H, S(0));
        k_gemm<E7a><<<dim3(D / 128, M / 128), 256, 0, stream>>>((const bf16*)(ws + WS_PB), PLE, (const bf16*)(ws + WS_WPL), PLE, PLE, E7a{S(1)});
        k_gemm<E7b><<<dim3(D / 128, M / 128), 256, 0, stream>>>(S(0), D, (const bf16*)(ws + WS_WPG), D, D, E7b{S(1), H});
    }
    k_final<<<M, 256, 0, stream>>>(H, (const float*)d_in[24]);
#endif
}
```
